# Optimizing an MI355X kernel written in HIP

```python
import jax, jax.numpy as jnp
from jax import lax
import numpy as np

D_MODEL = 1024
BATCH = 32
SEQ = 2048
DEPTH = 4

HEAD_DIM = 64
N_HEADS_FOX = 8
N_HEADS_DIL = 8
FOX_WIDTH = N_HEADS_FOX * HEAD_DIM
DIL_WIDTH = N_HEADS_DIL * HEAD_DIM
DIL_PATTERNS = ((128, 1), (512, 4), (2048, 16))
ATTN_BLOCK = 128
ROPE_THETA = 10000.0
N_EXPERTS = 64
TOP_K = 8
N_GROUPS = 8
TOPK_GROUPS = 4
EXPERT_FF = 256
SHARED_FF = 256
ROUTED_SCALE = 2.5
MOE_BLOCK = 128
DN_ALPHA = (2 * DEPTH) ** 0.25
DN_BETA = (8 * DEPTH) ** -0.25
LN_EPS = 1e-5
FORGET_BIAS_INIT = 3.0
ADA_INIT = 0.2
NEG_INF = -1e30
IN_SIZES = (FOX_WIDTH, FOX_WIDTH, FOX_WIDTH, N_HEADS_FOX, DIL_WIDTH, DIL_WIDTH, DIL_WIDTH, D_MODEL, D_MODEL)
IN_COLS = FOX_WIDTH * 3 + N_HEADS_FOX + DIL_WIDTH * 3 + 2 * D_MODEL

kernel_name = "fox_dilated_gated_moe_deepnorm_adaln"


def _split_points(sizes):
    pts, acc = [], 0
    for s in sizes[:-1]:
        acc += s
        pts.append(acc)
    return pts


def layer_norm(x, g, b):
    xf = x.astype(jnp.float32)
    mu = jnp.mean(xf, axis=-1, keepdims=True)
    var = jnp.mean(jnp.square(xf - mu), axis=-1, keepdims=True)
    return ((xf - mu) * lax.rsqrt(var + LN_EPS) * g.astype(jnp.float32) + b.astype(jnp.float32)).astype(x.dtype)


def rotary(x, pos):
    half = HEAD_DIM // 2
    inv_freq = ROPE_THETA ** (-jnp.arange(half, dtype=jnp.float32) * 2.0 / HEAD_DIM)
    ang = pos[:, None] * inv_freq[None, :]
    cos = jnp.cos(ang)[None, :, None, :]
    sin = jnp.sin(ang)[None, :, None, :]
    xf = x.astype(jnp.float32)
    x1, x2 = xf[..., :half], xf[..., half:]
    return jnp.concatenate([x1 * cos - x2 * sin, x2 * cos + x1 * sin], axis=-1).astype(x.dtype)


def forgetting_attention(q, k, v, log_f):
    B, S, H, Dh = q.shape
    q, k, v = (t.transpose(0, 2, 1, 3) for t in (q, k, v))
    cum = jnp.cumsum(log_f, axis=1).transpose(0, 2, 1)
    scale = Dh ** -0.5
    outs = []
    for blk in range(S // ATTN_BLOCK):
        lo, hi = blk * ATTN_BLOCK, (blk + 1) * ATTN_BLOCK
        s = jnp.einsum('bhqd,bhkd->bhqk', q[:, :, lo:hi], k[:, :, :hi]).astype(jnp.float32) * scale
        s = s + cum[:, :, lo:hi, None] - cum[:, :, None, :hi]
        causal = jnp.arange(lo, hi)[:, None] >= jnp.arange(hi)[None, :]
        p = jax.nn.softmax(jnp.where(causal, s, NEG_INF), axis=-1).astype(v.dtype)
        outs.append(jnp.einsum('bhqk,bhkd->bhqd', p, v[:, :, :hi]))
    o = jnp.concatenate(outs, axis=2)
    return o.transpose(0, 2, 1, 3).reshape(B, S, H * Dh)


def dilated_window_attention(q, k, v, dilation, n_back):
    B, S, H, Dh = q.shape
    L = S // dilation
    nb = -(-L // ATTN_BLOCK)
    Lp = nb * ATTN_BLOCK

    def to_sub(t):
        t = t.reshape(B, L, dilation, H, Dh).transpose(0, 2, 3, 1, 4)
        return jnp.pad(t, ((0, 0), (0, 0), (0, 0), (0, Lp - L), (0, 0)))

    qs, ks, vs = to_sub(q), to_sub(k), to_sub(v)
    qb = qs.reshape(B, dilation, H, nb, ATTN_BLOCK, Dh)

    def key_band(t):
        tp = jnp.pad(t, ((0, 0), (0, 0), (0, 0), (ATTN_BLOCK, 0), (0, 0)))
        tp = tp.reshape(B, dilation, H, nb + 1, ATTN_BLOCK, Dh)
        return jnp.concatenate([tp[:, :, :, :-1], tp[:, :, :, 1:]], axis=4)

    kb, vb = key_band(ks), key_band(vs)
    s = jnp.einsum('brhnqd,brhnkd->brhnqk', qb, kb).astype(jnp.float32) * (Dh ** -0.5)
    i = jnp.arange(ATTN_BLOCK)[None, :, None]
    j = jnp.arange(2 * ATTN_BLOCK)[None, None, :]
    n = jnp.arange(nb)[:, None, None]
    dist = i + ATTN_BLOCK - j
    key_idx = n * ATTN_BLOCK + j - ATTN_BLOCK
    valid = (dist >= 0) & (dist <= n_back) & (key_idx >= 0)
    s = jnp.where(valid, s, NEG_INF)
    m = jnp.max(s, axis=-1, keepdims=True)
    e = jnp.exp(s - m)
    l = jnp.sum(e, axis=-1, keepdims=True)
    o = jnp.einsum('brhnqk,brhnkd->brhnqd', (e / l).astype(v.dtype), vb)
    lse = (m + jnp.log(l))[..., 0]
    o = o.reshape(B, dilation, H, Lp, Dh)[:, :, :, :L].transpose(0, 3, 1, 2, 4).reshape(B, S, H, Dh)
    lse = lse.reshape(B, dilation, H, Lp)[..., :L].transpose(0, 3, 1, 2).reshape(B, S, H)
    return o, lse


def dilated_mixture(q, k, v):
    B, S, H, Dh = q.shape
    outs, lses = [], []
    for window, dilation in DIL_PATTERNS:
        o, lse = dilated_window_attention(q, k, v, dilation, window // dilation)
        outs.append(o)
        lses.append(lse)
    w = jax.nn.softmax(jnp.stack(lses, axis=0), axis=0)
    o = jnp.sum(w[..., None] * jnp.stack(outs, axis=0).astype(jnp.float32), axis=0)
    return o.reshape(B, S, H * Dh).astype(v.dtype)


def token_mixer(u, w_in, b_forget, b_gate, w_br_fox, w_br_dil, w_o):
    B, S, D = u.shape
    proj = u @ w_in
    qf, kf, vf, ff, qd, kd, vd, ga, gb = jnp.split(proj, _split_points(IN_SIZES), axis=-1)
    fox_heads = lambda t: t.reshape(B, S, N_HEADS_FOX, HEAD_DIM)
    dil_heads = lambda t: t.reshape(B, S, N_HEADS_DIL, HEAD_DIM)
    log_f = jax.nn.log_sigmoid((ff + b_forget).astype(jnp.float32))
    y_fox = forgetting_attention(fox_heads(qf), fox_heads(kf), fox_heads(vf), log_f)
    pos = jnp.arange(S, dtype=jnp.float32)
    y_dil = dilated_mixture(rotary(dil_heads(qd), pos), rotary(dil_heads(kd), pos), dil_heads(vd))
    g_fox = jax.nn.sigmoid(ga + b_gate[:D])
    g_dil = jax.nn.sigmoid(gb + b_gate[D:])
    merged = g_fox * (y_fox @ w_br_fox) + g_dil * (y_dil @ w_br_dil)
    return merged @ w_o


def swiglu(h, w_gate, w_up, w_down):
    return (jax.nn.silu(h @ w_gate) * (h @ w_up)) @ w_down


def routed_experts(h, eidx, gw, w_eg, w_eu, w_ed):
    N, D = h.shape
    NK = N * TOP_K
    flat_e = eidx.reshape(NK)
    flat_w = gw.reshape(NK)
    flat_tok = jnp.arange(NK, dtype=jnp.int32) // TOP_K
    order = jnp.argsort(flat_e)
    e_s, tok_s, w_s = flat_e[order], flat_tok[order], flat_w[order]
    counts = jnp.bincount(flat_e, length=N_EXPERTS)
    starts = jnp.cumsum(counts) - counts
    padded = (counts + MOE_BLOCK - 1) // MOE_BLOCK * MOE_BLOCK
    pends = jnp.cumsum(padded)
    pstarts = pends - padded
    slot = pstarts[e_s] + (jnp.arange(NK, dtype=jnp.int32) - starts[e_s])
    n_blocks = -(-NK // MOE_BLOCK) + N_EXPERTS
    P = n_blocks * MOE_BLOCK
    slot_tok = jnp.full((P,), N, dtype=jnp.int32).at[slot].set(tok_s)
    slot_w = jnp.zeros((P,), h.dtype).at[slot].set(w_s)
    blk_e = jnp.minimum(jnp.searchsorted(pends, jnp.arange(n_blocks) * MOE_BLOCK, side='right'), N_EXPERTS - 1)
    h_pad = jnp.concatenate([h, jnp.zeros((1, D), h.dtype)], axis=0)

    def expert_block(args):
        toks, e = args
        xb = jnp.take(h_pad, toks, axis=0)
        return swiglu(xb, w_eg[e], w_eu[e], w_ed[e])

    out = lax.map(expert_block, (slot_tok.reshape(n_blocks, MOE_BLOCK), blk_e))
    out = out.reshape(P, D) * slot_w[:, None]
    return jax.ops.segment_sum(out, slot_tok, num_segments=N + 1)[:N]


def moe(h, w_router, router_bias, w_eg, w_eu, w_ed, w_sg, w_su, w_sd):
    N, D = h.shape
    scores = jax.nn.sigmoid(h.astype(jnp.float32) @ w_router.astype(jnp.float32))
    sel = scores + router_bias.astype(jnp.float32)
    grp = sel.reshape(N, N_GROUPS, N_EXPERTS // N_GROUPS)
    grp_score = jnp.sum(lax.top_k(grp, 2)[0], axis=-1)
    _, gidx = lax.top_k(grp_score, TOPK_GROUPS)
    gmask = jnp.sum(jax.nn.one_hot(gidx, N_GROUPS, dtype=jnp.float32), axis=1)
    emask = jnp.repeat(gmask, N_EXPERTS // N_GROUPS, axis=1)
    _, eidx = lax.top_k(jnp.where(emask > 0, sel, NEG_INF), TOP_K)
    gw = jnp.take_along_axis(scores, eidx, axis=-1)
    gw = gw / jnp.sum(gw, axis=-1, keepdims=True) * ROUTED_SCALE
    routed = routed_experts(h, eidx, gw.astype(h.dtype), w_eg, w_eu, w_ed)
    return routed + swiglu(h, w_sg, w_su, w_sd)


def setup_inputs(seed: int = 0) -> dict:
    key = jax.random.key(seed)
    ks = jax.random.split(key, 22)
    nrm = lambda k, shape, scale: jax.random.normal(k, shape, jnp.float32) * scale
    D = D_MODEL
    return {
        "x": nrm(ks[0], (BATCH, SEQ, D), 1.0),
        "c": nrm(ks[1], (BATCH, D), 1.0),
        "w_ada": nrm(ks[2], (DEPTH, D, 6 * D), ADA_INIT * D ** -0.5),
        "b_ada": nrm(ks[3], (DEPTH, 6 * D), 0.02),
        "w_in": nrm(ks[4], (DEPTH, D, IN_COLS), D ** -0.5),
        "b_forget": FORGET_BIAS_INIT + nrm(ks[5], (DEPTH, N_HEADS_FOX), 0.5),
        "b_gate": nrm(ks[6], (DEPTH, 2 * D), 0.02),
        "w_br_fox": nrm(ks[7], (DEPTH, FOX_WIDTH, D), FOX_WIDTH ** -0.5),
        "w_br_dil": nrm(ks[8], (DEPTH, DIL_WIDTH, D), DIL_WIDTH ** -0.5),
        "w_o": nrm(ks[9], (DEPTH, D, D), DN_BETA * D ** -0.5),
        "ln_g": 1.0 + nrm(ks[10], (DEPTH, 2, D), 0.02),
        "ln_b": nrm(ks[11], (DEPTH, 2, D), 0.02),
        "w_router": nrm(ks[12], (DEPTH, D, N_EXPERTS), D ** -0.5),
        "router_bias": nrm(ks[13], (DEPTH, N_EXPERTS), 0.01),
        "w_exp_gate": nrm(ks[14], (DEPTH, N_EXPERTS, D, EXPERT_FF), D ** -0.5),
        "w_exp_up": nrm(ks[15], (DEPTH, N_EXPERTS, D, EXPERT_FF), D ** -0.5),
        "w_exp_down": nrm(ks[16], (DEPTH, N_EXPERTS, EXPERT_FF, D), DN_BETA * EXPERT_FF ** -0.5),
        "w_sh_gate": nrm(ks[17], (DEPTH, D, SHARED_FF), D ** -0.5),
        "w_sh_up": nrm(ks[18], (DEPTH, D, SHARED_FF), D ** -0.5),
        "w_sh_down": nrm(ks[19], (DEPTH, SHARED_FF, D), DN_BETA * SHARED_FF ** -0.5),
    }


def reference(x, c, w_ada, b_ada, w_in, b_forget, b_gate, w_br_fox, w_br_dil, w_o, ln_g, ln_b,
              w_router, router_bias, w_exp_gate, w_exp_up, w_exp_down, w_sh_gate, w_sh_up, w_sh_down):
    B, S, D = x.shape
    cs = jax.nn.silu(c)
    for l in range(DEPTH):
        mod = cs @ w_ada[l] + b_ada[l]
        sh1, sc1, g1, sh2, sc2, g2 = [m[:, None, :] for m in jnp.split(mod, 6, axis=-1)]
        u = x * (1.0 + sc1) + sh1
        y = token_mixer(u, w_in[l], b_forget[l], b_gate[l], w_br_fox[l], w_br_dil[l], w_o[l])
        x = layer_norm(DN_ALPHA * x + (1.0 + g1) * y, ln_g[l, 0], ln_b[l, 0])
        u = (x * (1.0 + sc2) + sh2).reshape(B * S, D)
        y = moe(u, w_router[l], router_bias[l], w_exp_gate[l], w_exp_up[l], w_exp_down[l],
                w_sh_gate[l], w_sh_up[l], w_sh_down[l]).reshape(B, S, D)
        x = layer_norm(DN_ALPHA * x + (1.0 + g2) * y, ln_g[l, 1], ln_b[l, 1])
    return x
```

```cpp
#include <hip/hip_runtime.h>
#include <cstdio>
#include <cstdint>

#define LAS __attribute__((address_space(3)))
typedef unsigned short bf16_t;
typedef short bf16x8 __attribute__((ext_vector_type(8)));
typedef short s16x4 __attribute__((ext_vector_type(4)));
typedef float f32x4 __attribute__((ext_vector_type(4)));
typedef float f32x16 __attribute__((ext_vector_type(16)));
typedef unsigned u32x4 __attribute__((ext_vector_type(4)));
typedef unsigned u32x2 __attribute__((ext_vector_type(2)));
typedef int i32x4 __attribute__((ext_vector_type(4)));
#define DI __device__ __forceinline__

constexpr int D = 1024, NB = 32, SEQ = 2048, NTOK = NB * SEQ, DEPTH = 4;
constexpr int NPROJ = 5120;
constexpr int INCOLS = 5128;
constexpr int NE = 64, NEX = 65, TOPK = 8;
constexpr int NCHUNK = 2, CH_TOK = NTOK / NCHUNK;
constexpr int PMAX_TILES = 1216, PMAX = PMAX_TILES * 256;
constexpr float QSCALE = 0.125f * 1.4426950408889634f;
constexpr float LOG2E = 1.4426950408889634f;
constexpr float DN_ALPHA = 1.6817928305074290f;
constexpr float LN_EPS = 1e-5f;
constexpr float NEGBIG = -1e30f;
constexpr float SLOT_SCALE = 16.0f, SLOT_INV = 1.0f / 16.0f;

constexpr size_t WS_CTL = 0;
constexpr size_t CTL_BYTES = 65536;
#ifndef MK_ONE_LAUNCH
#define MK_ONE_LAUNCH 1
#endif
constexpr int CW_CQ = 9280;
constexpr int CW_DONE = 9216;
constexpr int CW_CNT = 4096, CW_CUR = 4096 + 1024;
constexpr size_t WS_MOD = WS_CTL + CTL_BYTES;
constexpr size_t WS_ROPE = WS_MOD + (size_t)DEPTH * NB * 6144 * 4;
constexpr size_t WS_LOGF = WS_ROPE + 2 * 2048 * 32 * 4;
constexpr size_t WS_LOGITS = WS_LOGF + (size_t)NTOK * 8 * 4;
constexpr size_t WS_EIDX = WS_LOGITS + (size_t)NTOK * 64 * 4;
constexpr size_t WS_GW = WS_EIDX + (size_t)NTOK * 8 * 4;
constexpr size_t WS_TPOS = WS_GW + (size_t)NTOK * 8 * 4;
constexpr size_t WS_STOK = WS_TPOS + (size_t)NTOK * 8 * 4;
constexpr size_t WS_LSE = WS_STOK + (size_t)NCHUNK * PMAX * 4;
constexpr size_t WS_W = WS_LSE + (size_t)2 * NTOK * 8 * 4;
constexpr size_t W_IN = 0;
constexpr size_t W_BF = W_IN + (size_t)NPROJ * D * 2;
constexpr size_t W_BD = W_BF + (size_t)D * 512 * 2;
constexpr size_t W_O = W_BD + (size_t)D * 512 * 2;
constexpr size_t W_R = W_O + (size_t)D * D * 2;
constexpr size_t W_GU = W_R + (size_t)256 * D * 2;
constexpr size_t W_DN = W_GU + (size_t)NEX * 512 * D * 2;
constexpr size_t W_END = W_DN + (size_t)NEX * D * 256 * 2;
constexpr size_t WS_U = WS_W + W_END;
constexpr size_t WS_R = WS_U + (size_t)NTOK * D * 2;
constexpr size_t R_PROJ = 0;
constexpr size_t QKV_T = (size_t)NTOK * 512;
constexpr size_t GATE_OFF = 6 * QKV_T;
constexpr size_t R_Y = (size_t)NTOK * NPROJ * 2;
constexpr size_t R_ATT_END = R_Y + (size_t)NTOK * D * 2;
constexpr size_t R_H = 0;
constexpr size_t R_SLOT = (size_t)PMAX * 256 * 2;
constexpr size_t R_MOE_END = R_SLOT + (size_t)PMAX * 1024 * 2;
constexpr size_t WS_END = WS_R + (R_ATT_END > R_MOE_END ? R_ATT_END : R_MOE_END);
constexpr size_t WS_XB = WS_END;
constexpr size_t WS_END2 = WS_XB + (size_t)NTOK * D * 2;
constexpr size_t WS_DRY = WS_END2; constexpr size_t DRY_ROWS = 16384, DRY_BYTES = DRY_ROWS * D * 6 + DRY_ROWS * 32;

constexpr int LDS_MISC = 4096, RING_OFF = LDS_MISC, RING_BYTES = 143360, LDS_BYTES = RING_OFF + RING_BYTES;
constexpr int LM_BAR = 0, LM_TSTART = 64  , LM_PSTART = 512  , LM_LH = 1280  , LM_LBASE = 1664  , LM_RB = 2048  ;

DI int fresh_tid() { int t = threadIdx.x; asm volatile("" : "+v"(t)); return t; }
DI unsigned cvt_pk_bf16(float lo, float hi) { unsigned r; asm volatile("v_cvt_pk_bf16_f32 %0, %1, %2" : "=v"(r) : "v"(lo), "v"(hi)); return r; }
DI float bf_lo(unsigned w) { return __uint_as_float(w << 16); }
DI float bf_hi(unsigned w) { return __uint_as_float(w & 0xffff0000u); }
DI float wave_sum(float x) { x += __shfl_xor(x, 32); x += __shfl_xor(x, 16); x += __shfl_xor(x, 8); x += __shfl_xor(x, 4); x += __shfl_xor(x, 2); x += __shfl_xor(x, 1); return x; }
DI int shfl_up_i(int v, int off, int ln) { return __builtin_amdgcn_ds_bpermute((ln - off) * 4, v); }
DI float shfl_up_f(float v, int off, int ln) { return __int_as_float(__builtin_amdgcn_ds_bpermute((ln - off) * 4, __float_as_int(v))); }
DI float ub0(unsigned w) { float r; asm("v_cvt_f32_ubyte0 %0, %1" : "=v"(r) : "v"(w)); return r; }
DI float ub1(unsigned w) { float r; asm("v_cvt_f32_ubyte1 %0, %1" : "=v"(r) : "v"(w)); return r; }
DI float ub2(unsigned w) { float r; asm("v_cvt_f32_ubyte2 %0, %1" : "=v"(r) : "v"(w)); return r; }
DI float ub3(unsigned w) { float r; asm("v_cvt_f32_ubyte3 %0, %1" : "=v"(r) : "v"(w)); return r; }
DI float fast_sigmoid(float x) { return __builtin_amdgcn_rcpf(1.0f + __builtin_amdgcn_exp2f(-x * LOG2E)); }

#define XB_TMO      128
#define XB_XCNT(j)  (256  + 64 * (j))
#define XB_XSUB(j)  (1280 + 64 * (j))
#define XB_XGEN(j)  (2304 + 64 * (j))
#define XB_TOP      3328
#define XB_TOPGEN   3392
#define XCD_BAR_WORDS 3456
#define XB_SPIN_CAP (1u << 18)
__device__ __forceinline__ unsigned xb_ld(unsigned* p)              { return __hip_atomic_load(p, __ATOMIC_RELAXED, __HIP_MEMORY_SCOPE_AGENT); }
__device__ __forceinline__ unsigned xb_add(unsigned* p, unsigned v) { return __hip_atomic_fetch_add(p, v, __ATOMIC_RELAXED, __HIP_MEMORY_SCOPE_AGENT); }
__device__ __forceinline__ unsigned xb_xcc_id() { return (unsigned)__builtin_amdgcn_s_getreg((3 << 11) | 20) & 0xFu; }
#define XB_SPIN(cond, bar) do { unsigned _sp = 0; while (cond) { __builtin_amdgcn_s_sleep(1); \
    if ((++_sp & 255u) == 0u) { if (xb_ld(&(bar)[XB_TMO])) break; if (_sp > XB_SPIN_CAP) { atomicAdd(&(bar)[XB_TMO], 1u); break; } } } } while (0)
struct XcdBarrier { unsigned* bar; unsigned x; volatile LAS unsigned* st; };
__device__ __forceinline__ XcdBarrier xcd_barrier_post(unsigned* bar, volatile LAS unsigned* st) {
    XcdBarrier b; b.bar = bar; b.x = xb_xcc_id(); b.st = st;
    if (threadIdx.x == 0) (void)xb_add(&bar[XB_XCNT(b.x)], 1u);
    return b;
}
__device__ __forceinline__ void xcd_barrier_complete(unsigned* bar, unsigned x, unsigned& nloc, unsigned& nx) {
    const unsigned G = gridDim.x * gridDim.y * gridDim.z;
    unsigned sum, cnt, mine, sp = 0u;
    for (;;) {
        sum = 0u; cnt = 0u; mine = 0u;
#pragma unroll
        for (unsigned j = 0; j < 16; ++j) { const unsigned c = xb_ld(&bar[XB_XCNT(j)]); sum += c; cnt += (c > 0u) ? 1u : 0u; mine = (j == x) ? c : mine; }
        if (sum == G) break;
        __builtin_amdgcn_s_sleep(1);
        if ((++sp & 255u) == 0u) { if (xb_ld(&bar[XB_TMO])) break; if (sp > XB_SPIN_CAP) { atomicAdd(&bar[XB_TMO], 1u); break; } }
    }
    nloc = mine > 0u ? mine : 1u; nx = cnt > 0u ? cnt : 1u;
}
__device__ __forceinline__ void xcd_barrier(const XcdBarrier& b) {
    asm volatile("s_waitcnt vmcnt(0)" ::: "memory");
    __syncthreads();
    if (threadIdx.x == 0) {
        unsigned* bar = b.bar;
        __builtin_amdgcn_s_waitcnt(0);
        unsigned nloc = b.st[0], nx = b.st[1];
        if (nloc == 0u) { xcd_barrier_complete(bar, b.x, nloc, nx); b.st[0] = nloc; b.st[1] = nx; }
        const unsigned old = xb_add(&bar[XB_XSUB(b.x)], 1u);
        const unsigned gen = old / nloc;
        if (old + 1u == (gen + 1u) * nloc) {
            __builtin_amdgcn_fence(__ATOMIC_RELEASE, "agent");
            asm volatile("s_waitcnt vmcnt(0)" ::: "memory");
            const unsigned og = xb_add(&bar[XB_TOP], 1u);
            const unsigned tg = og / nx;
            if (og + 1u == (tg + 1u) * nx) xb_add(&bar[XB_TOPGEN], 1u);
            else XB_SPIN(xb_ld(&bar[XB_TOPGEN]) == tg, bar);
            __builtin_amdgcn_fence(__ATOMIC_ACQUIRE, "agent");
            xb_add(&bar[XB_XGEN(b.x)], 1u);
            asm volatile("s_waitcnt vmcnt(0)" ::: "memory");
        } else {
            XB_SPIN(xb_ld(&bar[XB_XGEN(b.x)]) == gen, bar);
            __builtin_amdgcn_fence(__ATOMIC_ACQUIRE, "agent");
            asm volatile("s_waitcnt vmcnt(0)" ::: "memory");
        }
    }
    __syncthreads();
}

namespace pg8 {
constexpr int BM = 256, BK = 64, HALF = 128, HTB = HALF * BK * 2, STAGE_BYTES = 8 * HTB, NXCD = 8, WGM = 8;
__host__ __device__ __forceinline__ int lds_byte(int r, int c) { const int st = (r >> 4) * 2 + (c >> 5), rr = r & 15, cc = c & 31, ob = rr * 64 + cc * 2; return st * 1024 + (ob ^ (((ob >> 9) & 1) << 5)); }
__host__ __device__ __forceinline__ void stage_rc(int b, int& R, int& C) { const int st = b / 1024, sb = b % 1024, swz = sb ^ (((sb >> 9) & 1) << 5); R = (st >> 1) * 16 + swz / 64; C = (st & 1) * 32 + (swz % 64) / 2; }
__host__ __device__ __forceinline__ int perm32(int rho) { const int n = rho >> 4, i = rho & 15; return 8 * (i >> 2) + 4 * n + (i & 3); }

struct Unit { int pm, pn, e; };
struct Gemm { const bf16_t* A; const bf16_t* Bt; int lda, ldb, K; };

struct StaticOrder {
    static constexpr bool GATHER = false, SAMEPANEL = false;
    int nM, nN, nwg, G, c;
    DI void init(int M, int N, int G_, int c_) { nM = M / BM; nN = N / BM; nwg = nM * nN; G = G_; c = c_; }
    DI bool next(int i, Unit& u) const {
        const long L = (long)i * G + c; if (L >= nwg) return false;
        int wgid = (int)L; { const int q = nwg / NXCD, r = nwg % NXCD, xcd = wgid % NXCD, off = wgid / NXCD; wgid = (xcd < r ? xcd * (q + 1) : r * (q + 1) + (xcd - r) * q) + off; }
        const int nig = WGM * nN, gid = wgid / nig, fm = gid * WGM, gsz = (nM - fm) < WGM ? (nM - fm) : WGM;
        u.pm = fm + ((wgid % nig) % gsz); u.pn = (wgid % nig) / gsz; u.e = 0; return true;
    }
    DI const char* abase(const Gemm& g, const Unit& u) const { return (const char*)g.A + (size_t)u.pm * (size_t)(BM * 2) * g.lda; }
    DI const char* bbase(const Gemm& g, const Unit& u) const { return (const char*)g.Bt + (size_t)u.pn * (size_t)(BM * 2) * g.ldb; }
    DI void goffs(const Gemm&, const Unit&, int, unsigned (&)[2][2]) const {}
};
template <bool GATH> struct MoeOrder {
    static constexpr bool GATHER = GATH, SAMEPANEL = false;
    int nN, ntiles, G, c; const LAS int* tstart; const int* stok; size_t estride  ;
    DI bool next(int i, Unit& u) const {
        const long L = (long)i * G + c; if (L >= (long)ntiles * nN) return false;
        u.pm = (int)(L / nN); u.pn = (int)(L % nN);
        int e = 0;
#pragma unroll 1
        for (int k = 1; k < NEX; ++k) e += (tstart[k] <= u.pm) ? 1 : 0;
        u.e = e; return true;
    }
    DI const char* abase(const Gemm& g, const Unit& u) const { return GATH ? (const char*)g.A : (const char*)g.A + (size_t)u.pm * (size_t)(BM * 2) * g.lda; }
    DI const char* bbase(const Gemm& g, const Unit& u) const { return (const char*)g.Bt + (size_t)u.e * estride + (size_t)u.pn * (size_t)(BM * 2) * g.ldb; }
    DI void goffs(const Gemm& g, const Unit& u, int tid, unsigned (&o)[2][2]) const {
        if constexpr (GATH) {
            int R0, C0; stage_rc(tid * 16, R0, C0);
            int t[2][2];
#pragma unroll
            for (int h = 0; h < 2; ++h)
#pragma unroll
                for (int i = 0; i < 2; ++i) t[h][i] = stok[u.pm * BM + h * HALF + R0 + 64 * i];
            asm volatile("s_waitcnt vmcnt(0)" ::: "memory");
#pragma unroll
            for (int h = 0; h < 2; ++h)
#pragma unroll
                for (int i = 0; i < 2; ++i) o[h][i] = (unsigned)(t[h][i] * g.lda + C0) * 2u;
        }
    }
};

template <bool GATH> struct TileOrder {
    static constexpr bool GATHER = GATH, SAMEPANEL = true;
    int pm, e, nN; const int* stok; size_t estride;
    DI bool next(int i, Unit& u) const { if (i >= nN) return false; u.pm = pm; u.pn = i; u.e = e; return true; }
    DI const char* abase(const Gemm& g, const Unit& u) const { return GATH ? (const char*)g.A : (const char*)g.A + (size_t)u.pm * (size_t)(BM * 2) * g.lda; }
    DI const char* bbase(const Gemm& g, const Unit& u) const { return (const char*)g.Bt + (size_t)u.e * estride + (size_t)u.pn * (size_t)(BM * 2) * g.ldb; }
    DI void goffs(const Gemm& g, const Unit& u, int tid, unsigned (&o)[2][2]) const {
        if constexpr (GATH) {
            int R0, C0; stage_rc(tid * 16, R0, C0);
            int t[2][2];
#pragma unroll
            for (int h = 0; h < 2; ++h)
#pragma unroll
                for (int i = 0; i < 2; ++i) t[h][i] = stok[u.pm * BM + h * HALF + R0 + 64 * i];
            asm volatile("s_waitcnt vmcnt(0)" ::: "memory");
#pragma unroll
            for (int h = 0; h < 2; ++h)
#pragma unroll
                for (int i = 0; i < 2; ++i) o[h][i] = (unsigned)(t[h][i] * g.lda + C0) * 2u;
        }
    }
};

typedef f32x4 Acc[2][2][4][2];

template <class Epi, class Sched, bool ALIGN_EPI>
__device__ __forceinline__ void gemm_phase(LAS unsigned char* lds, const Gemm g, const Sched& S, const Epi& E) {
    const int tid = fresh_tid(), wid = __builtin_amdgcn_readfirstlane(tid >> 6), lane = tid & 63, wr = wid >> 2, wc = wid & 3, fr = lane & 15, fq = lane >> 4;
    const int K = g.K, nt = K / BK;
    unsigned voffA[2], voffB[2];
#pragma unroll
    for (int i = 0; i < 2; ++i) { int R, C; stage_rc(tid * 16 + i * 8192, R, C); const int Rb = Epi::PERM ? ((R & ~31) + perm32(R & 31)) : R;
        voffA[i] = (unsigned)(R * g.lda + C) * 2u; voffB[i] = (unsigned)(Rb * g.ldb + C) * 2u; }
    const size_t kstep = (size_t)(BK * 2);
    const size_t hstepA = (size_t)HALF * g.lda * 2;
    const size_t hstepB = (size_t)HALF * g.ldb * 2;
    const unsigned ldsw = (unsigned)wid * 1024u;
    const int aoff = lds_byte(wr * 64 + fr, fq * 8), boff = lds_byte(wc * 32 + fr, fq * 8);
#define PG8_SA(b, h) (((b) * 2 + (h)) * HTB)
#define PG8_SB(b, h) ((4 + (b) * 2 + (h)) * HTB)
#define PG8_STAGE(bufoff, gbase, voff) do { _Pragma("unroll") for (int _i = 0; _i < 2; ++_i) \
        __builtin_amdgcn_global_load_lds((const unsigned*)((const char*)(gbase) + (voff)[_i]), (LAS unsigned*)(lds + (bufoff) + ldsw + _i * 8192), 16, 0, 0); } while (0)
#define PG8_STAGE_A(bufoff, gbase, h, og) do { if constexpr (Sched::GATHER) { PG8_STAGE(bufoff, gbase, (og)[h]); } else { PG8_STAGE(bufoff, (gbase) + (h) * hstepA, voffA); } } while (0)
#define PG8_LDA(dst, b, h) do { _Pragma("unroll") for (int m = 0; m < 4; ++m) _Pragma("unroll") for (int k = 0; k < 2; ++k) dst[m][k] = *(const LAS bf16x8*)(lds + PG8_SA(b, h) + aoff + m * 2048 + k * 1024); } while (0)
#define PG8_LDB(dst, b, h) do { _Pragma("unroll") for (int n = 0; n < 2; ++n) _Pragma("unroll") for (int k = 0; k < 2; ++k) dst[n][k] = *(const LAS bf16x8*)(lds + PG8_SB(b, h) + boff + n * 2048 + k * 1024); } while (0)
#define PG8_MMA(ai, bj, At, Bt) do { __builtin_amdgcn_s_setprio(1); _Pragma("unroll") for (int m = 0; m < 4; ++m) _Pragma("unroll") for (int n = 0; n < 2; ++n) _Pragma("unroll") for (int k = 0; k < 2; ++k) \
        acc[ai][bj][m][n] = __builtin_amdgcn_mfma_f32_16x16x32_bf16(Bt[n][k], At[m][k], acc[ai][bj][m][n], 0, 0, 0); __builtin_amdgcn_s_setprio(0); } while (0)
#define PG8_WAIT_V(n) asm volatile("s_waitcnt vmcnt(" #n ")" ::: "memory")
#define PG8_WAIT_L(n) asm volatile("s_waitcnt lgkmcnt(" #n ")" ::: "memory")
#define PG8_BAR __builtin_amdgcn_s_barrier()
#define PG8_SCHED __builtin_amdgcn_sched_barrier(0)
    Unit cur, nxt; int ui = 0;
    if (!S.next(0, cur)) return;
    Acc acc;
#pragma unroll
    for (int a = 0; a < 2; ++a)
#pragma unroll
        for (int b = 0; b < 2; ++b)
#pragma unroll
            for (int m = 0; m < 4; ++m)
#pragma unroll
                for (int n = 0; n < 2; ++n) acc[a][b][m][n] = (f32x4){0.f, 0.f, 0.f, 0.f};
    bf16x8 At[4][2], B0[2][2], B1[2][2];
    unsigned oA[2][2], noA[2][2];
    if constexpr (Sched::GATHER) { S.goffs(g, cur, tid, oA);
#pragma unroll
        for (int h = 0; h < 2; ++h)
#pragma unroll
            for (int i = 0; i < 2; ++i) noA[h][i] = oA[h][i]; }
    const char* cA = S.abase(g, cur); const char* cB = S.bbase(g, cur);
    PG8_STAGE(PG8_SB(0, 0), cB, voffB); PG8_STAGE(PG8_SB(0, 1), cB + hstepB, voffB); PG8_STAGE_A(PG8_SA(0, 0), cA, 0, oA); PG8_STAGE_A(PG8_SA(0, 1), cA, 1, oA);
    if (wr == 1) PG8_BAR;
    PG8_WAIT_V(2); PG8_BAR;
    PG8_STAGE(PG8_SB(1, 0), cB + kstep, voffB); PG8_STAGE_A(PG8_SA(1, 0), cA + kstep, 0, oA); PG8_STAGE(PG8_SB(1, 1), cB + hstepB + kstep, voffB);
    PG8_WAIT_V(6); PG8_BAR;
    for (;;) {
        const bool has_next = S.next(ui + 1, nxt);
        const char* nA = has_next ? S.abase(g, nxt) : cA; const char* nB = has_next ? S.bbase(g, nxt) : cB;
#pragma unroll 1
        for (int t = 0; t < nt; t += 2) {
            const bool last = (t == nt - 2);
            const char* a1 = cA + (size_t)(t + 1) * kstep;
            const char* a2 = last ? nA : cA + (size_t)(t + 2) * kstep; const char* b2 = last ? nB : cB + (size_t)(t + 2) * kstep;
            const char* a3 = a2 + kstep; const char* b3 = b2 + kstep;
            if constexpr (Epi::MIDHOOK) { if (t == (nt >> 1)) E.mid(acc, cur, wr, wc, fr, fq); }
            unsigned xo[2][2];
            if constexpr (Sched::GATHER) {
                if constexpr (Sched::SAMEPANEL) {
#pragma unroll
                    for (int h = 0; h < 2; ++h)
#pragma unroll
                        for (int i = 0; i < 2; ++i) xo[h][i] = oA[h][i];
                } else {
                    if (last && has_next && nxt.pm != cur.pm) S.goffs(g, nxt, tid, noA);
#pragma unroll
                    for (int h = 0; h < 2; ++h)
#pragma unroll
                        for (int i = 0; i < 2; ++i) xo[h][i] = last ? noA[h][i] : oA[h][i];
                }
            }
            PG8_LDB(B0, 0, 0); PG8_LDB(B1, 0, 1); PG8_SCHED; PG8_LDA(At, 0, 0); PG8_STAGE_A(PG8_SA(1, 1), a1, 1, oA);
            PG8_WAIT_V(8); PG8_WAIT_L(0); PG8_BAR; PG8_MMA(0, 0, At, B0); PG8_MMA(0, 1, At, B1); PG8_BAR; PG8_SCHED;
            PG8_LDA(At, 0, 1); PG8_STAGE(PG8_SB(0, 0), b2, voffB); PG8_STAGE(PG8_SB(0, 1), b2 + hstepB, voffB); PG8_STAGE_A(PG8_SA(0, 0), a2, 0, xo);
            PG8_WAIT_V(8); PG8_WAIT_L(0); PG8_BAR; PG8_MMA(1, 0, At, B0); PG8_MMA(1, 1, At, B1); PG8_BAR; PG8_SCHED;
            PG8_LDB(B0, 1, 0); PG8_LDB(B1, 1, 1); PG8_SCHED; PG8_LDA(At, 1, 0); PG8_STAGE_A(PG8_SA(0, 1), a2, 1, xo);
            PG8_WAIT_V(8); PG8_WAIT_L(0); PG8_BAR; PG8_MMA(0, 0, At, B0); PG8_MMA(0, 1, At, B1); PG8_BAR; PG8_SCHED;
            PG8_LDA(At, 1, 1); PG8_STAGE(PG8_SB(1, 0), b3, voffB); PG8_STAGE(PG8_SB(1, 1), b3 + hstepB, voffB); PG8_STAGE_A(PG8_SA(1, 0), a3, 0, xo);
            PG8_WAIT_V(8); PG8_WAIT_L(0); PG8_BAR; PG8_MMA(1, 0, At, B0); PG8_MMA(1, 1, At, B1); PG8_BAR; PG8_SCHED;
        }
        if constexpr (ALIGN_EPI) { if (wr == 0) PG8_BAR; }
        E(acc, cur, wr, wc, fr, fq);
        if (!has_next) break;
#pragma unroll
        for (int a = 0; a < 2; ++a)
#pragma unroll
            for (int b = 0; b < 2; ++b)
#pragma unroll
                for (int m = 0; m < 4; ++m)
#pragma unroll
                    for (int n = 0; n < 2; ++n) acc[a][b][m][n] = (f32x4){0.f, 0.f, 0.f, 0.f};
        cur = nxt; cA = nA; cB = nB; ++ui;
        if constexpr (Sched::GATHER) {
#pragma unroll
            for (int h = 0; h < 2; ++h)
#pragma unroll
                for (int i = 0; i < 2; ++i) oA[h][i] = noA[h][i]; }
        if constexpr (ALIGN_EPI) { if (wr == 1) PG8_BAR; }
    }
    PG8_WAIT_V(0);
    if constexpr (!ALIGN_EPI) { if (wr == 0) PG8_BAR; }
    PG8_BAR;
#undef PG8_SA
#undef PG8_SB
#undef PG8_STAGE
#undef PG8_STAGE_A
#undef PG8_LDA
#undef PG8_LDB
#undef PG8_MMA
#undef PG8_WAIT_V
#undef PG8_WAIT_L
#undef PG8_BAR
#undef PG8_SCHED
}

DI u32x4 pack8(const f32x4 v0, const f32x4 v1) { u32x4 w; w.x = cvt_pk_bf16(v0[0], v0[1]); w.y = cvt_pk_bf16(v0[2], v0[3]); w.z = cvt_pk_bf16(v1[0], v1[1]); w.w = cvt_pk_bf16(v1[2], v1[3]); return w; }
DI void unpack8(const u32x4 w, f32x4& v0, f32x4& v1) { v0 = (f32x4){bf_lo(w.x), bf_hi(w.x), bf_lo(w.y), bf_hi(w.y)}; v1 = (f32x4){bf_lo(w.z), bf_hi(w.z), bf_lo(w.w), bf_hi(w.w)}; }

struct EpiInProj {
    static constexpr bool PERM = true, MIDHOOK = false;
    bf16_t* P; const float* bgate; const float* cosT; const float* sinT;
    DI void operator()(const Acc& acc, const Unit& u, int wr, int wc, int fr, int fq) const {
        const int pn = u.pn;
        const int srow = (u.pm & 7) * BM + wr * 64 + fr;
        if (pn >= 12) {
            const int col0 = (pn - 12) * BM + wc * 32 + 8 * fq;
            f32x4 bv[2][2];
#pragma unroll
            for (int bj = 0; bj < 2; ++bj)
#pragma unroll
                for (int n = 0; n < 2; ++n) bv[bj][n] = *(const f32x4*)(bgate + col0 + bj * HALF + 4 * n);
            unsigned char* rowp = (unsigned char*)(P + GATE_OFF) + (size_t)(u.pm * BM + wr * 64 + fr) * 2048 + ((pn - 12) * 16 + wc * 4 + fq) * 16;
#pragma unroll
            for (int ai = 0; ai < 2; ++ai) {
#pragma unroll
                for (int m = 0; m < 4; ++m) { u32x4 w;
#pragma unroll
                    for (int bj = 0; bj < 2; ++bj)
#pragma unroll
                        for (int n = 0; n < 2; ++n) { const f32x4 v = acc[ai][bj][m][n] + bv[bj][n]; unsigned t = 0;
                            t = __builtin_amdgcn_cvt_pk_u8_f32(fmaxf(fast_sigmoid(v[0]) * 255.0f, 1.0f), 0, t); t = __builtin_amdgcn_cvt_pk_u8_f32(fmaxf(fast_sigmoid(v[1]) * 255.0f, 1.0f), 1, t);
                            t = __builtin_amdgcn_cvt_pk_u8_f32(fmaxf(fast_sigmoid(v[2]) * 255.0f, 1.0f), 2, t); t = __builtin_amdgcn_cvt_pk_u8_f32(fmaxf(fast_sigmoid(v[3]) * 255.0f, 1.0f), 3, t);
                            w[bj * 2 + n] = t; }
                    *(u32x4*)rowp = w;
                    rowp += (size_t)16 * 2048; asm volatile("" : "+v"(rowp)); }
                rowp += (size_t)(HALF - 64) * 2048; }
            return;
        }
        const int cin0 = (pn & 1) * BM + wc * 32 + 8 * fq;
        bf16_t* tp = P + (size_t)(pn >> 1) * QKV_T + ((size_t)(((u.pm >> 3) * 8 + (cin0 >> 6)) * 2 + ((cin0 >> 5) & 1)) * SEQ + srow) * 32 + (cin0 & 31);
        if (pn >= 6 && pn < 10) {
            const float sc = (pn < 8) ? QSCALE : 1.0f;
            const int g = 4 * (wc & 1) + fq;
            int pos = srow;
#pragma unroll
            for (int ai = 0; ai < 2; ++ai) {
#pragma unroll
                for (int m = 0; m < 4; ++m) {
                    const f32x4 cs = *(const f32x4*)(cosT + pos * 32 + 4 * g) * sc, sn = *(const f32x4*)(sinT + pos * 32 + 4 * g) * sc;
#pragma unroll
                    for (int bj = 0; bj < 2; ++bj) { const f32x4 x1 = acc[ai][bj][m][0], x2 = acc[ai][bj][m][1];
                        *(u32x4*)(tp + (size_t)bj * 2 * SEQ * 64) = pack8(x1 * cs - x2 * sn, x2 * cs + x1 * sn); }
                    tp += 16 * 32; pos += 16; asm volatile("" : "+v"(tp)); }
                tp += (HALF - 64) * 32; pos += HALF - 64; }
        } else {
            const float sc = (pn < 2) ? QSCALE : 1.0f;
#pragma unroll
            for (int ai = 0; ai < 2; ++ai) {
#pragma unroll
                for (int m = 0; m < 4; ++m) {
#pragma unroll
                    for (int bj = 0; bj < 2; ++bj) *(u32x4*)(tp + (size_t)bj * 2 * SEQ * 64) = pack8(acc[ai][bj][m][0] * sc, acc[ai][bj][m][1] * sc);
                    tp += 16 * 32; asm volatile("" : "+v"(tp)); }
                tp += (HALF - 64) * 32; }
        }
    }
};
struct EpiBranchFused {
    static constexpr bool PERM = true, MIDHOOK = true;
    bf16_t* T; const bf16_t* P;
    DI void mid(Acc& acc, const Unit& u, int wr, int wc, int fr, int fq) const {
        const int row0 = u.pm * BM + wr * 64 + fr;
        const unsigned char* gp = (const unsigned char*)(P + GATE_OFF) + (size_t)row0 * 2048 + (u.pn * 16 + wc * 4 + fq) * 16;
#pragma unroll
        for (int ai = 0; ai < 2; ++ai) {
#pragma unroll
            for (int m = 0; m < 4; ++m) {
                const u32x4 fw = *(const u32x4*)gp, dw = *(const u32x4*)(gp + 1024);
#pragma unroll
                for (int bj = 0; bj < 2; ++bj)
#pragma unroll
                    for (int n = 0; n < 2; ++n) { const unsigned f = fw[bj * 2 + n], d = dw[bj * 2 + n];
                        acc[ai][bj][m][n][0] *= ub0(f) * __builtin_amdgcn_rcpf(ub0(d)); acc[ai][bj][m][n][1] *= ub1(f) * __builtin_amdgcn_rcpf(ub1(d));
                        acc[ai][bj][m][n][2] *= ub2(f) * __builtin_amdgcn_rcpf(ub2(d)); acc[ai][bj][m][n][3] *= ub3(f) * __builtin_amdgcn_rcpf(ub3(d)); }
                gp += (size_t)16 * 2048; asm volatile("" : "+v"(gp)); }
            gp += (size_t)(HALF - 64) * 2048; }
    }
    DI void operator()(const Acc& acc, const Unit& u, int wr, int wc, int fr, int fq) const {
        const int row0 = u.pm * BM + wr * 64 + fr, col0 = u.pn * BM + wc * 32 + 8 * fq;
        const unsigned char* gp = (const unsigned char*)(P + GATE_OFF) + (size_t)row0 * 2048 + 1024 + (u.pn * 16 + wc * 4 + fq) * 16; bf16_t* tp = T + (size_t)row0 * D + col0;
        constexpr float I255 = 1.0f / 255.0f;
#pragma unroll
        for (int ai = 0; ai < 2; ++ai) {
#pragma unroll
            for (int m = 0; m < 4; ++m) {
                const u32x4 dw = *(const u32x4*)gp;
#pragma unroll
                for (int bj = 0; bj < 2; ++bj) { const unsigned d0 = dw[bj * 2], d1 = dw[bj * 2 + 1];
                    const f32x4 g0 = (f32x4){ub0(d0), ub1(d0), ub2(d0), ub3(d0)} * I255, g1 = (f32x4){ub0(d1), ub1(d1), ub2(d1), ub3(d1)} * I255;
                    *(u32x4*)(tp + bj * HALF) = pack8(acc[ai][bj][m][0] * g0, acc[ai][bj][m][1] * g1); }
                gp += (size_t)16 * 2048; tp += (size_t)16 * D; asm volatile("" : "+v"(gp), "+v"(tp)); }
            gp += (size_t)(HALF - 64) * 2048; tp += (size_t)(HALF - 64) * D; }
    }
};
struct EpiOut {
    static constexpr bool PERM = true, MIDHOOK = false;
    const float* xin32; bf16_t* xb; const float* gmod;
    DI void operator()(const Acc& acc, const Unit& u, int wr, int wc, int fr, int fq) const {
        const int row0 = u.pm * BM + wr * 64 + fr, col0 = u.pn * BM + wc * 32 + 8 * fq;
        const float* gm = gmod + (size_t)(u.pm >> 3) * 6144 + col0;
        f32x4 gv[2][2];
#pragma unroll
        for (int bj = 0; bj < 2; ++bj)
#pragma unroll
            for (int n = 0; n < 2; ++n) gv[bj][n] = *(const f32x4*)(gm + bj * HALF + n * 4) + 1.0f;
        size_t off = (size_t)row0 * D + col0;
#pragma unroll
        for (int ai = 0; ai < 2; ++ai) {
#pragma unroll
            for (int m = 0; m < 4; ++m) {
#pragma unroll
                for (int bj = 0; bj < 2; ++bj) { f32x4 x0, x1;
                    if (xin32) { x0 = *(const f32x4*)(xin32 + off + bj * HALF); x1 = *(const f32x4*)(xin32 + off + bj * HALF + 4); }
                    else { const u32x4 xw = *(const u32x4*)(xb + off + bj * HALF); unpack8(xw, x0, x1); }
                    *(u32x4*)(xb + off + bj * HALF) = pack8(x0 * DN_ALPHA + gv[bj][0] * acc[ai][bj][m][0], x1 * DN_ALPHA + gv[bj][1] * acc[ai][bj][m][1]); }
                off += (size_t)16 * D; asm volatile("" : "+v"(off)); }
            off += (size_t)(HALF - 64) * D; }
    }
};
struct EpiRouter {
    static constexpr bool PERM = false, MIDHOOK = false;
    float* L;
    DI void operator()(const Acc& acc, const Unit& u, int wr, int wc, int fr, int fq) const {
        if (wc >= 2) return;
        const int row0 = u.pm * BM + wr * 64 + fr, col0 = wc * 32 + 4 * fq;
#pragma unroll
        for (int ai = 0; ai < 2; ++ai)
#pragma unroll
            for (int m = 0; m < 4; ++m) { float* rp = L + (size_t)(row0 + ai * HALF + m * 16) * 64 + col0;
#pragma unroll
                for (int n = 0; n < 2; ++n) *(f32x4*)(rp + n * 16) = acc[ai][0][m][n]; }
    }
};
struct EpiGU {
    static constexpr bool PERM = true, MIDHOOK = false;
    bf16_t* H;
    DI void operator()(const Acc& acc, const Unit& u, int wr, int wc, int fr, int fq) const {
        const int row0 = u.pm * BM + wr * 64 + fr, col0 = u.pn * HALF + wc * 32 + 8 * fq;
        bf16_t* rp = H + (size_t)row0 * 256 + col0;
#pragma unroll
        for (int ai = 0; ai < 2; ++ai) {
#pragma unroll
            for (int m = 0; m < 4; ++m) { f32x4 v[2];
#pragma unroll
                for (int n = 0; n < 2; ++n) { const f32x4 gt = acc[ai][0][m][n], up = acc[ai][1][m][n];
#pragma unroll
                    for (int j = 0; j < 4; ++j) v[n][j] = gt[j] * fast_sigmoid(gt[j]) * up[j]; }
                *(u32x4*)rp = pack8(v[0], v[1]); rp += 16 * 256; asm volatile("" : "+v"(rp)); }
            rp += (HALF - 64) * 256; }
    }
};
struct EpiSlotF8 {
    static constexpr bool PERM = true, MIDHOOK = false;
    unsigned char* O;
    DI void operator()(const Acc& acc, const Unit& u, int wr, int wc, int fr, int fq) const {
        if (O == nullptr) return;
        const int row0 = u.pm * BM + wr * 64 + fr;
        unsigned char* rowp = O + (size_t)row0 * 1024 + u.pn * 256 + (wc * 4 + fq) * 16;
#pragma unroll
        for (int ai = 0; ai < 2; ++ai) {
#pragma unroll
            for (int m = 0; m < 4; ++m) {
                u32x4 w;
#pragma unroll
                for (int bj = 0; bj < 2; ++bj)
#pragma unroll
                    for (int n = 0; n < 2; ++n) { const f32x4 v = acc[ai][bj][m][n] * SLOT_SCALE;
                        int t = __builtin_amdgcn_cvt_pk_fp8_f32(v[0], v[1], 0, false); t = __builtin_amdgcn_cvt_pk_fp8_f32(v[2], v[3], t, true);
                        w[bj * 2 + n] = (unsigned)t; }
                __builtin_nontemporal_store(w, (u32x4*)rowp);
                rowp += (size_t)16 * 1024; asm volatile("" : "+v"(rowp)); }
            rowp += (size_t)(HALF - 64) * 1024; }
    }
};
struct EpiPlain {
    static constexpr bool PERM = true, MIDHOOK = false;
    bf16_t* O; int ldc;
    DI void operator()(const Acc& acc, const Unit& u, int wr, int wc, int fr, int fq) const {
        if (O == nullptr) return;
        const int row0 = u.pm * BM + wr * 64 + fr, col0 = u.pn * BM + wc * 32 + 8 * fq;
        bf16_t* rowp = O + (size_t)row0 * ldc + col0;
#pragma unroll
        for (int ai = 0; ai < 2; ++ai) {
#pragma unroll
            for (int m = 0; m < 4; ++m) {
#pragma unroll
                for (int bj = 0; bj < 2; ++bj) __builtin_nontemporal_store(pack8(acc[ai][bj][m][0], acc[ai][bj][m][1]), (u32x4*)(rowp + bj * HALF));
                rowp += (size_t)16 * ldc; asm volatile("" : "+v"(rowp)); }
            rowp += (size_t)(HALF - 64) * ldc; }
    }
};
}

namespace att {
constexpr int TILE_B = 8192, GRP_BUF = 2 * TILE_B, NBUF = 6, PD = 4;
constexpr int ATT_LDS = NBUF * GRP_BUF;
constexpr int BIAS_OFF = ATT_LDS;
constexpr int QBUF_OFF = BIAS_OFF + 8192;
static_assert(QBUF_OFF + 8 * 4096 <= RING_BYTES, "attention LDS map");
struct Sub { int qbase, qstr, k0, kstr, nkt, koff, maxd; };
#define MFMA32(a, b, c) __builtin_amdgcn_mfma_f32_32x32x16_bf16((a), (b), (c), 0, 0, 0)
#define ATT_BAR() do { asm volatile("s_waitcnt lgkmcnt(0)" ::: "memory"); __builtin_amdgcn_s_barrier(); asm volatile("" ::: "memory"); } while (0)

DI float max_xor32(float v) { float p = v, q = v; asm volatile("s_nop 1\n\tv_permlane32_swap_b32 %0, %1\n\ts_nop 1" : "+v"(p), "+v"(q)); return fmaxf(p, q); }
DI f32x16 cat16(f32x4 a, f32x4 b, f32x4 c, f32x4 d) {
    typedef float f32x8_ __attribute__((ext_vector_type(8)));
    const f32x8_ ab = __builtin_shufflevector(a, b, 0, 1, 2, 3, 4, 5, 6, 7), cd = __builtin_shufflevector(c, d, 0, 1, 2, 3, 4, 5, 6, 7);
    return __builtin_shufflevector(ab, cd, 0, 1, 2, 3, 4, 5, 6, 7, 8, 9, 10, 11, 12, 13, 14, 15);
}
DI bf16x8 pack_step8(float a0, float a1, float a2, float a3, float a4, float a5, float a6, float a7) {
    u32x4 p; p.x = cvt_pk_bf16(a0, a1); p.y = cvt_pk_bf16(a2, a3); p.z = cvt_pk_bf16(a4, a5); p.w = cvt_pk_bf16(a6, a7);
    return __builtin_bit_cast(bf16x8, p);
}
struct GSub { int qbase, qstr, koff, maxd, lo, hi; };
struct GenFox { int b; static constexpr int A = 1;
    DI int nt(int u) const { return 4 * u + 4; }
    DI int kstr() const { return 1; }
    DI int tile_k0(int, int j) const { return b * SEQ + 64 * j; }
    DI GSub sub(int u, int grp) const { GSub s; const int qb = 2 * u + grp; s.qbase = b * SEQ + 128 * qb; s.qstr = 1; s.koff = 128 * qb; s.maxd = 1 << 30; s.lo = 0; s.hi = 2 * qb + 2; return s; } };
struct GenDil { int b, dl, nblk; static constexpr int A = 1;
    DI int kstr() const { return dl; }
    DI int nt(int u) const { if (nblk == 1) return 4; const int n = (2 * u) % nblk; return n == 0 ? 4 : 6; }
    DI int tile_k0(int u, int j) const {
        if (nblk == 1) return b * SEQ + (2 * u + (j >> 1)) + 64 * (j & 1) * dl;
        const int su = 2 * u, cls = su / nblk, n = su % nblk; const int first = (n == 0) ? 0 : 2 * n - 2;
        return b * SEQ + cls + 64 * (first + j) * dl; }
    DI GSub sub(int u, int grp) const { GSub t; t.qstr = dl; t.maxd = 128;
        if (nblk == 1) { t.qbase = b * SEQ + 2 * u + grp; t.koff = 0; t.lo = 2 * grp; t.hi = 2 * grp + 2; return t; }
        const int su = 2 * u, cls = su / nblk, n = su % nblk + grp;
        t.qbase = b * SEQ + cls + 128 * n * dl;
        if (n == 0) { t.koff = 0; t.lo = 0; t.hi = 2; } else if (n == 1) { t.koff = 128; t.lo = 0; t.hi = 4; } else { t.koff = 128; t.lo = 2 * grp; t.hi = 2 * grp + 4; }
        return t; } };

struct GenDil2 { int b, dl, nblk; static constexpr int A = 2;
    DI int kstr() const { return dl; }
    DI int nt(int) const { return nblk == 1 ? 2 : 4; }
    DI int tile2(int u, int s, int g) const {
        if (nblk == 1) return b * SEQ + (2 * u + g) + 64 * s * dl;
        const int su = 2 * u, cls = su / nblk, n = su % nblk + g; const int tile = (n == 0) ? s : 2 * n - 2 + s;
        return b * SEQ + cls + 64 * tile * dl; }
    DI GSub sub(int u, int grp) const { GSub t; t.qstr = dl; t.maxd = 128; t.lo = 0;
        if (nblk == 1) { t.qbase = b * SEQ + 2 * u + grp; t.koff = 0; t.hi = 2; return t; }
        const int su = 2 * u, cls = su / nblk, n = su % nblk + grp;
        t.qbase = b * SEQ + cls + 128 * n * dl; t.koff = (n == 0) ? 0 : 128; t.hi = (n == 0) ? 2 : 4; return t; } };

template <int MODE, class Gen, int NU>
__device__ __forceinline__ void attn_pass(LAS unsigned char* ring, const Gen gen, const bf16_t* qT, const bf16_t* kT, const bf16_t* vT,

                                          bf16_t* Y, const int ycol, bf16_t* part_w, float* lse_w, const bf16_t* part_a, const bf16_t* part_b, const float* lse_a, const float* lse_b, const int head, const int var) {
    const int tid = fresh_tid(), wid = __builtin_amdgcn_readfirstlane(tid >> 6), lane = tid & 63, grp = wid >> 2, wq = wid & 3;
    const int r = lane & 31, hh = lane >> 5;
    const LAS float* bias2 = (const LAS float*)(ring + BIAS_OFF);
    const int qi = 32 * wq + r;
    const unsigned q4 = (unsigned)((lane & 15) >> 2), p4 = (unsigned)(lane & 3), blk = (unsigned)((lane >> 4) & 1);
    GSub sb = gen.sub(0, grp);
    bf16x8 qf[4];
    LAS unsigned char* qbuf = ring + QBUF_OFF + wid * 4096;
    int fill = 0, rd = 0;
    const unsigned kx0 = (unsigned)(r * 128 + (((0 + hh) ^ ((r >> 1) & 7)) * 16)), kx1 = (unsigned)(r * 128 + (((2 + hh) ^ ((r >> 1) & 7)) * 16)),
                   kx2 = (unsigned)(r * 128 + (((4 + hh) ^ ((r >> 1) & 7)) * 16)), kx3 = (unsigned)(r * 128 + (((6 + hh) ^ ((r >> 1) & 7)) * 16));
    const int kstr = gen.kstr();
#define ATT_ISSUE(TOK0) do { LAS unsigned char* fb_ = ring + fill * GRP_BUF; \
        const int kc_ = (lane & 7) ^ ((4 * wid + (lane >> 4)) & 7); \
        const bf16_t* kp_ = kT + (size_t)((TOK0) + (8 * wid + (lane >> 3)) * kstr + (kc_ >> 2) * SEQ) * 32 + (kc_ & 3) * 8; \
        const bf16_t* vp_ = vT + (size_t)((TOK0) + (16 * (wid & 3) + (lane >> 2)) * kstr + (wid >> 2) * SEQ) * 32 + (lane & 3) * 8; \
        __builtin_amdgcn_global_load_lds((const unsigned*)kp_, (LAS unsigned*)(fb_ + wid * 1024), 16, 0, 0); \
        __builtin_amdgcn_global_load_lds((const unsigned*)vp_, (LAS unsigned*)(fb_ + TILE_B + (wid >> 2) * 4096 + (wid & 3) * 1024), 16, 0, 0); \
        fill = (fill == NBUF - 1) ? 0 : fill + 1; } while (0)
#define ATT_QISSUE(S_) do { const bf16_t* qp_ = qT + (size_t)((S_).qbase + qi * (S_).qstr) * 32 + 8 * hh; \
        _Pragma("unroll") for (int s_ = 0; s_ < 4; ++s_) __builtin_amdgcn_global_load_lds((const unsigned*)(qp_ + (size_t)(s_ >> 1) * SEQ * 32 + 16 * (s_ & 1)), (LAS unsigned*)(qbuf + s_ * 1024), 16, 0, 0); } while (0)
    constexpr int A = Gen::A;
    ATT_QISSUE(sb);
    if constexpr (A == 2) {
#pragma unroll
        for (int j = 0; j < 4; ++j) ATT_ISSUE(gen.tile2(0, j >> 1, j & 1));
        asm volatile("s_waitcnt vmcnt(4)" ::: "memory");
    } else {
#pragma unroll
        for (int j = 0; j < PD; ++j) ATT_ISSUE(gen.tile_k0(0, j));
        asm volatile("s_waitcnt vmcnt(6)" ::: "memory");
    }
    ATT_BAR();
    if (grp == 1) __builtin_amdgcn_s_barrier();
#pragma unroll 1
    for (int u = 0; u < NU; ++u) {
        const int nt = gen.nt(u);
        const bool has_nu = (u + 1 < NU);
        GSub nsb = sb; if (has_nu) nsb = gen.sub(u + 1, grp);
#pragma unroll
        for (int s = 0; s < 4; ++s) qf[s] = *(const LAS bf16x8*)(qbuf + s * 1024 + lane * 16);
        asm volatile("s_waitcnt lgkmcnt(0)" : "+v"(qf[0]), "+v"(qf[1]), "+v"(qf[2]), "+v"(qf[3]) :: "memory");
        f32x16 o0, o1;
#pragma unroll
        for (int i = 0; i < 16; ++i) { o0[i] = 0.f; o1[i] = 0.f; }
        float mrun = NEGBIG, lsum = 0.f;
#pragma unroll 1
        for (int kt = 0; kt < nt; ++kt) {
            const int ktl = kt - sb.lo;
            const bool inwin = (var != 3) && (var != 5) && (kt >= sb.lo) && (kt < sb.hi);
            const int dh0 = 32 * wq + 31 + sb.koff - ktl * 64, dl0 = dh0 - 62, dh1 = dh0 - 32, dl1 = dl0 - 32;
            const bool act0 = inwin && (dh0 >= 0) && (dl0 <= sb.maxd), act1 = inwin && (dh1 >= 0) && (dl1 <= sb.maxd);
            const bool full0 = (dl0 >= 0) && (dh0 <= sb.maxd), full1 = (dl1 >= 0) && (dh1 <= sb.maxd);
            const bool both = act0 && act1;
            f32x16 s0, s1; s16x4 vt[16];
            const LAS unsigned char* Kt = ring + (rd + (A == 2 ? grp : 0)) * GRP_BUF; const LAS unsigned char* Vt = Kt + TILE_B;
            const unsigned vbase = (unsigned)(uintptr_t)Vt + (unsigned)(4 * hh + (int)q4) * 64u + 32u * blk + 8u * p4;
            const int dbase = qi + sb.koff - ktl * 64;
            float mx = NEGBIG;
#define ATT_STEP_ISSUE() do { if constexpr (A == 2) { \
                if (kt + 2 < nt) { ATT_ISSUE(gen.tile2(u, kt + 2, 0)); ATT_ISSUE(gen.tile2(u, kt + 2, 1)); } \
                else if (has_nu) { if (kt + 2 == nt) ATT_QISSUE(nsb); ATT_ISSUE(gen.tile2(u + 1, kt + 2 - nt, 0)); ATT_ISSUE(gen.tile2(u + 1, kt + 2 - nt, 1)); } } \
            else { if (kt + PD < nt) { ATT_ISSUE(gen.tile_k0(u, kt + PD)); } \
            else if (has_nu) { if (kt + PD == nt) ATT_QISSUE(nsb);                      \
                ATT_ISSUE(gen.tile_k0(u + 1, kt + PD - nt)); } } } while (0)
            bf16x8 kfa[4], kfb[4]; f32x4 bza[4], bzb[4];
            if (both) {
                const unsigned kb_ = (unsigned)(uintptr_t)Kt;
                if (MODE == 0) { const unsigned ba_ = (unsigned)(uintptr_t)bias2 + (unsigned)(kt * 64 + 4 * hh) * 4u;
                    asm volatile("ds_read_b128 %0, %4\n\tds_read_b128 %1, %4 offset:32\n\tds_read_b128 %2, %4 offset:64\n\tds_read_b128 %3, %4 offset:96"
                                 : "=&v"(bza[0]), "=&v"(bza[1]), "=&v"(bza[2]), "=&v"(bza[3]) : "v"(ba_) : "memory"); }
                asm volatile("ds_read_b128 %0, %8\n\tds_read_b128 %1, %9\n\tds_read_b128 %2, %10\n\tds_read_b128 %3, %11\n\t"
                             "ds_read_b128 %4, %8 offset:4096\n\tds_read_b128 %5, %9 offset:4096\n\tds_read_b128 %6, %10 offset:4096\n\tds_read_b128 %7, %11 offset:4096"
                             : "=&v"(kfa[0]), "=&v"(kfa[1]), "=&v"(kfa[2]), "=&v"(kfa[3]), "=&v"(kfb[0]), "=&v"(kfb[1]), "=&v"(kfb[2]), "=&v"(kfb[3])
                             : "v"(kb_ + kx0), "v"(kb_ + kx1), "v"(kb_ + kx2), "v"(kb_ + kx3) : "memory");
                if (MODE == 0) {
                    asm volatile("s_waitcnt lgkmcnt(4)" : "+v"(kfa[0]), "+v"(kfa[1]), "+v"(kfa[2]), "+v"(kfa[3]), "+v"(bza[0]), "+v"(bza[1]), "+v"(bza[2]), "+v"(bza[3]) :: "memory");
                    s0 = cat16(bza[0], bza[1], bza[2], bza[3]);
                } else {
                    asm volatile("s_waitcnt lgkmcnt(4)" : "+v"(kfa[0]), "+v"(kfa[1]), "+v"(kfa[2]), "+v"(kfa[3]) :: "memory");
#pragma unroll
                    for (int i = 0; i < 16; ++i) s0[i] = 0.f;
                }
#pragma unroll
                for (int s = 0; s < 4; ++s) s0 = MFMA32(kfa[s], qf[s], s0);
                if (MODE == 0) { const unsigned ba_ = (unsigned)(uintptr_t)bias2 + (unsigned)(kt * 64 + 4 * hh) * 4u;
                    asm volatile("ds_read_b128 %0, %4 offset:128\n\tds_read_b128 %1, %4 offset:160\n\tds_read_b128 %2, %4 offset:192\n\tds_read_b128 %3, %4 offset:224"
                                 : "=&v"(bzb[0]), "=&v"(bzb[1]), "=&v"(bzb[2]), "=&v"(bzb[3]) : "v"(ba_) : "memory"); }
                asm volatile(
                    "ds_read_b64_tr_b16 %0, %8 offset:0\n\tds_read_b64_tr_b16 %1, %8 offset:512\n\tds_read_b64_tr_b16 %2, %8 offset:1024\n\tds_read_b64_tr_b16 %3, %8 offset:1536\n\t"
                    "ds_read_b64_tr_b16 %4, %8 offset:4096\n\tds_read_b64_tr_b16 %5, %8 offset:4608\n\tds_read_b64_tr_b16 %6, %8 offset:5120\n\tds_read_b64_tr_b16 %7, %8 offset:5632"
                    : "=&v"(vt[0]), "=&v"(vt[1]), "=&v"(vt[2]), "=&v"(vt[3]), "=&v"(vt[8]), "=&v"(vt[9]), "=&v"(vt[10]), "=&v"(vt[11]) : "v"(vbase) : "memory");
                if (MODE == 0) {
                    asm volatile("s_waitcnt lgkmcnt(8)" : "+v"(kfb[0]), "+v"(kfb[1]), "+v"(kfb[2]), "+v"(kfb[3]), "+v"(bzb[0]), "+v"(bzb[1]), "+v"(bzb[2]), "+v"(bzb[3]) :: "memory");
                    s1 = cat16(bzb[0], bzb[1], bzb[2], bzb[3]);
                } else {
                    asm volatile("s_waitcnt lgkmcnt(8)" : "+v"(kfb[0]), "+v"(kfb[1]), "+v"(kfb[2]), "+v"(kfb[3]) :: "memory");
#pragma unroll
                    for (int i = 0; i < 16; ++i) s1[i] = 0.f;
                }
#pragma unroll
                for (int s = 0; s < 4; ++s) s1 = MFMA32(kfb[s], qf[s], s1);
                asm volatile(
                    "ds_read_b64_tr_b16 %0, %8 offset:2048\n\tds_read_b64_tr_b16 %1, %8 offset:2560\n\tds_read_b64_tr_b16 %2, %8 offset:3072\n\tds_read_b64_tr_b16 %3, %8 offset:3584\n\t"
                    "ds_read_b64_tr_b16 %4, %8 offset:6144\n\tds_read_b64_tr_b16 %5, %8 offset:6656\n\tds_read_b64_tr_b16 %6, %8 offset:7168\n\tds_read_b64_tr_b16 %7, %8 offset:7680"
                    : "=&v"(vt[4]), "=&v"(vt[5]), "=&v"(vt[6]), "=&v"(vt[7]), "=&v"(vt[12]), "=&v"(vt[13]), "=&v"(vt[14]), "=&v"(vt[15]) : "v"(vbase) : "memory");
                if (!full0) {
#pragma unroll
                    for (int i = 0; i < 16; ++i) { const int kr = (i & 3) + 8 * (i >> 2) + 4 * hh; if ((unsigned)(dbase - kr) > (unsigned)sb.maxd) s0[i] = NEGBIG; }
                }
                float mxa = NEGBIG, mxb = NEGBIG;
#pragma unroll
                for (int i = 0; i < 16; ++i) mxa = fmaxf(mxa, s0[i]);
                if (!full1) {
#pragma unroll
                    for (int i = 0; i < 16; ++i) { const int kr = (i & 3) + 8 * (i >> 2) + 4 * hh; if ((unsigned)(dbase - kr - 32) > (unsigned)sb.maxd) s1[i] = NEGBIG; }
                }
#pragma unroll
                for (int i = 0; i < 16; ++i) mxb = fmaxf(mxb, s1[i]);
                mx = fmaxf(mxa, mxb);
            }
            if (act0 && !both) {
                if (MODE == 0) {
#pragma unroll
                    for (int g4 = 0; g4 < 4; ++g4) { const f32x4 b0 = *(const LAS f32x4*)(bias2 + kt * 64 + 8 * g4 + 4 * hh);
#pragma unroll
                        for (int j = 0; j < 4; ++j) s0[4 * g4 + j] = b0[j]; }
                } else {
#pragma unroll
                    for (int i = 0; i < 16; ++i) s0[i] = 0.f;
                }
#pragma unroll
                for (int s = 0; s < 4; ++s) { const bf16x8 kf = *(const LAS bf16x8*)(Kt + r * 128 + (((2 * s + hh) ^ ((r >> 1) & 7)) * 16)); s0 = MFMA32(kf, qf[s], s0); }
                asm volatile(
                    "ds_read_b64_tr_b16 %0, %8 offset:0\n\tds_read_b64_tr_b16 %1, %8 offset:512\n\tds_read_b64_tr_b16 %2, %8 offset:1024\n\tds_read_b64_tr_b16 %3, %8 offset:1536\n\t"
                    "ds_read_b64_tr_b16 %4, %8 offset:4096\n\tds_read_b64_tr_b16 %5, %8 offset:4608\n\tds_read_b64_tr_b16 %6, %8 offset:5120\n\tds_read_b64_tr_b16 %7, %8 offset:5632"
                    : "=&v"(vt[0]), "=&v"(vt[1]), "=&v"(vt[2]), "=&v"(vt[3]), "=&v"(vt[8]), "=&v"(vt[9]), "=&v"(vt[10]), "=&v"(vt[11]) : "v"(vbase) : "memory");
                if (!full0) {
#pragma unroll
                    for (int i = 0; i < 16; ++i) { const int kr = (i & 3) + 8 * (i >> 2) + 4 * hh; if ((unsigned)(dbase - kr) > (unsigned)sb.maxd) s0[i] = NEGBIG; }
                }
#pragma unroll
                for (int i = 0; i < 16; ++i) mx = fmaxf(mx, s0[i]);
            }
            if (act1 && !both) {
                if (MODE == 0) {
#pragma unroll
                    for (int g4 = 0; g4 < 4; ++g4) { const f32x4 b1 = *(const LAS f32x4*)(bias2 + kt * 64 + 32 + 8 * g4 + 4 * hh);
#pragma unroll
                        for (int j = 0; j < 4; ++j) s1[4 * g4 + j] = b1[j]; }
                } else {
#pragma unroll
                    for (int i = 0; i < 16; ++i) s1[i] = 0.f;
                }
#pragma unroll
                for (int s = 0; s < 4; ++s) { const bf16x8 kf = *(const LAS bf16x8*)(Kt + (32 + r) * 128 + (((2 * s + hh) ^ ((r >> 1) & 7)) * 16)); s1 = MFMA32(kf, qf[s], s1); }
                asm volatile(
                    "ds_read_b64_tr_b16 %0, %8 offset:2048\n\tds_read_b64_tr_b16 %1, %8 offset:2560\n\tds_read_b64_tr_b16 %2, %8 offset:3072\n\tds_read_b64_tr_b16 %3, %8 offset:3584\n\t"
                    "ds_read_b64_tr_b16 %4, %8 offset:6144\n\tds_read_b64_tr_b16 %5, %8 offset:6656\n\tds_read_b64_tr_b16 %6, %8 offset:7168\n\tds_read_b64_tr_b16 %7, %8 offset:7680"
                    : "=&v"(vt[4]), "=&v"(vt[5]), "=&v"(vt[6]), "=&v"(vt[7]), "=&v"(vt[12]), "=&v"(vt[13]), "=&v"(vt[14]), "=&v"(vt[15]) : "v"(vbase) : "memory");
                if (!full1) {
#pragma unroll
                    for (int i = 0; i < 16; ++i) { const int kr = (i & 3) + 8 * (i >> 2) + 4 * hh; if ((unsigned)(dbase - kr - 32) > (unsigned)sb.maxd) s1[i] = NEGBIG; }
                }
#pragma unroll
                for (int i = 0; i < 16; ++i) mx = fmaxf(mx, s1[i]);
            }
            if (act0 || act1) {
                mx = max_xor32(mx);
                if (__builtin_amdgcn_ballot_w64(mx - mrun > 6.0f) != 0ull) {
                    const float mnew = fmaxf(mrun, mx), alpha = __builtin_amdgcn_exp2f(mrun - mnew);
                    mrun = mnew; lsum *= alpha;
#pragma unroll
                    for (int i = 0; i < 16; ++i) { o0[i] *= alpha; o1[i] *= alpha; }
                }
            }
            if constexpr (A == 2) {
                if (MODE == 1 && u > 0 && kt == 0) asm volatile("s_waitcnt vmcnt(8)" ::: "memory");
                else asm volatile("s_waitcnt vmcnt(0)" ::: "memory");
            } else
            {   int allow = 0;
                if (kt + 2 < nt || has_nu) allow += 2;
                if (kt + 3 < nt || has_nu) allow += 2;
                if (has_nu && (nt == kt + 2 || nt == kt + 3)) allow += 4;
                if (MODE != 2 && u > 0 && kt < 3) allow += 8;
                if (allow == 4) asm volatile("s_waitcnt vmcnt(4)" ::: "memory"); else if (allow == 12) asm volatile("s_waitcnt vmcnt(12)" ::: "memory");
                else if (allow == 8) asm volatile("s_waitcnt vmcnt(8)" ::: "memory"); else if (allow == 16) asm volatile("s_waitcnt vmcnt(16)" ::: "memory");
                else if (allow == 10) asm volatile("s_waitcnt vmcnt(10)" ::: "memory"); else if (allow == 2) asm volatile("s_waitcnt vmcnt(2)" ::: "memory");
                else asm volatile("s_waitcnt vmcnt(0)" ::: "memory"); }
            __builtin_amdgcn_s_barrier(); asm volatile("" ::: "memory");
            ATT_STEP_ISSUE();
#define VFR(i) __builtin_shufflevector(vt[2 * (i)], vt[2 * (i) + 1], 0, 1, 2, 3, 4, 5, 6, 7)
            if (act0) {
                float ps = 0.f;
#pragma unroll
                for (int i = 0; i < 16; ++i) { s0[i] = __builtin_amdgcn_exp2f(s0[i] - mrun); ps += s0[i]; }
                lsum += ps;
                const bf16x8 p00 = pack_step8(s0[0], s0[1], s0[2], s0[3], s0[4], s0[5], s0[6], s0[7]);
                const bf16x8 p01 = pack_step8(s0[8], s0[9], s0[10], s0[11], s0[12], s0[13], s0[14], s0[15]);
                asm volatile("s_waitcnt lgkmcnt(0)" : "+v"(vt[0]), "+v"(vt[1]), "+v"(vt[2]), "+v"(vt[3]), "+v"(vt[8]), "+v"(vt[9]), "+v"(vt[10]), "+v"(vt[11]) :: "memory");
                o0 = MFMA32(VFR(0), p00, o0); o0 = MFMA32(VFR(1), p01, o0);
                o1 = MFMA32(VFR(4), p00, o1); o1 = MFMA32(VFR(5), p01, o1);
            }
            if (act1) {
                float ps = 0.f;
#pragma unroll
                for (int i = 0; i < 16; ++i) { s1[i] = __builtin_amdgcn_exp2f(s1[i] - mrun); ps += s1[i]; }
                lsum += ps;
                const bf16x8 p10 = pack_step8(s1[0], s1[1], s1[2], s1[3], s1[4], s1[5], s1[6], s1[7]);
                const bf16x8 p11 = pack_step8(s1[8], s1[9], s1[10], s1[11], s1[12], s1[13], s1[14], s1[15]);
                asm volatile("s_waitcnt lgkmcnt(0)" : "+v"(vt[4]), "+v"(vt[5]), "+v"(vt[6]), "+v"(vt[7]), "+v"(vt[12]), "+v"(vt[13]), "+v"(vt[14]), "+v"(vt[15]) :: "memory");
                o0 = MFMA32(VFR(2), p10, o0); o0 = MFMA32(VFR(3), p11, o0);
                o1 = MFMA32(VFR(6), p10, o1); o1 = MFMA32(VFR(7), p11, o1);
            }
#undef VFR
            rd += A; if (rd >= NBUF) rd -= NBUF;
            ATT_BAR();
        }
        if (var >= 4) { sb = nsb; continue; }
        const size_t qtok = (size_t)(sb.qbase + qi * sb.qstr);
        const float ltot = lsum + __shfl_xor(lsum, 32);
        const float inv = 1.0f / ltot;
        if (MODE == 0) {
            bf16_t* op = Y + qtok * D + ycol + 4 * hh;
#pragma unroll
            for (int g4 = 0; g4 < 4; ++g4) {
                u32x2 w0; w0.x = cvt_pk_bf16(o0[4 * g4] * inv, o0[4 * g4 + 1] * inv); w0.y = cvt_pk_bf16(o0[4 * g4 + 2] * inv, o0[4 * g4 + 3] * inv);
                u32x2 w1; w1.x = cvt_pk_bf16(o1[4 * g4] * inv, o1[4 * g4 + 1] * inv); w1.y = cvt_pk_bf16(o1[4 * g4 + 2] * inv, o1[4 * g4 + 3] * inv);
                *(u32x2*)(op + 8 * g4) = w0; *(u32x2*)(op + 32 + 8 * g4) = w1; }
        } else if (MODE == 1) {
            bf16_t* op = part_w + qtok * 512 + head * 64 + 4 * hh;
#pragma unroll
            for (int g4 = 0; g4 < 4; ++g4) {
                u32x2 w0; w0.x = cvt_pk_bf16(o0[4 * g4] * inv, o0[4 * g4 + 1] * inv); w0.y = cvt_pk_bf16(o0[4 * g4 + 2] * inv, o0[4 * g4 + 3] * inv);
                u32x2 w1; w1.x = cvt_pk_bf16(o1[4 * g4] * inv, o1[4 * g4 + 1] * inv); w1.y = cvt_pk_bf16(o1[4 * g4 + 2] * inv, o1[4 * g4 + 3] * inv);
                *(u32x2*)(op + 8 * g4) = w0; *(u32x2*)(op + 32 + 8 * g4) = w1; }
            if (hh == 0) lse_w[qtok * 8 + head] = mrun + __builtin_amdgcn_logf(ltot);
        } else {
            const float l1 = mrun + __builtin_amdgcn_logf(ltot), l2 = lse_a[qtok * 8 + head], l3 = lse_b[qtok * 8 + head];
            const float M = fmaxf(l1, fmaxf(l2, l3));
            float w1 = __builtin_amdgcn_exp2f(l1 - M), w2 = __builtin_amdgcn_exp2f(l2 - M), w3 = __builtin_amdgcn_exp2f(l3 - M);
            const float wi = 1.0f / (w1 + w2 + w3); w1 *= wi * inv; w2 *= wi; w3 *= wi;
            const bf16_t* pa = part_a + qtok * 512 + head * 64 + 4 * hh; const bf16_t* pb = part_b + qtok * 512 + head * 64 + 4 * hh;
            bf16_t* op = Y + qtok * D + ycol + 4 * hh;
#pragma unroll
            for (int g4 = 0; g4 < 4; ++g4) {
                const u32x2 a0 = *(const u32x2*)(pa + 8 * g4), a1 = *(const u32x2*)(pa + 32 + 8 * g4), b0 = *(const u32x2*)(pb + 8 * g4), b1 = *(const u32x2*)(pb + 32 + 8 * g4);
                u32x2 w0, w1v;
                w0.x = cvt_pk_bf16(o0[4 * g4] * w1 + bf_lo(a0.x) * w2 + bf_lo(b0.x) * w3, o0[4 * g4 + 1] * w1 + bf_hi(a0.x) * w2 + bf_hi(b0.x) * w3);
                w0.y = cvt_pk_bf16(o0[4 * g4 + 2] * w1 + bf_lo(a0.y) * w2 + bf_lo(b0.y) * w3, o0[4 * g4 + 3] * w1 + bf_hi(a0.y) * w2 + bf_hi(b0.y) * w3);
                w1v.x = cvt_pk_bf16(o1[4 * g4] * w1 + bf_lo(a1.x) * w2 + bf_lo(b1.x) * w3, o1[4 * g4 + 1] * w1 + bf_hi(a1.x) * w2 + bf_hi(b1.x) * w3);
                w1v.y = cvt_pk_bf16(o1[4 * g4 + 2] * w1 + bf_lo(a1.y) * w2 + bf_lo(b1.y) * w3, o1[4 * g4 + 3] * w1 + bf_hi(a1.y) * w2 + bf_hi(b1.y) * w3);
                *(u32x2*)(op + 8 * g4) = w0; *(u32x2*)(op + 32 + 8 * g4) = w1v; }
        }
        sb = nsb;
    }
    if (grp == 0) __builtin_amdgcn_s_barrier();
#undef ATT_STEP_ISSUE
#undef ATT_ISSUE
#undef ATT_QISSUE
}
namespace fx {
constexpr int NW=8,QBLK=32,QB=QBLK*NW,KVBLK=64;
__device__ __forceinline__ int crow(int r,int hi){return (r&3)+8*(r>>2)+4*hi;}
#define SBAR() __builtin_amdgcn_sched_barrier(0)
__device__ __forceinline__ void cmask(f32x16&p0,f32x16&p1,int jb,int qrel,int hi){
  const float NEG=-__builtin_inff(); int kb=64*jb+4*hi;
  #pragma unroll
  for(int r=0;r<16;++r){int kv=kb+(r&3)+8*(r>>2); if(kv>qrel)p0[r]=NEG; if(kv+32>qrel)p1[r]=NEG;}
}
constexpr int NSLOT=3, SLOTB=8192;
constexpr int LDS_K=0, LDS_V=NSLOT*SLOTB, LDS_WS=2*NSLOT*SLOTB, LDS_OST=LDS_WS+NW*64*4, LDS_BYTES=LDS_OST+NW*4096;
__device__ __forceinline__ void glds16(const void*gsrc,unsigned lds_dst){unsigned keep;
  asm volatile("s_mov_b32 %0, m0\n\ts_mov_b32 m0, %2\n\ts_nop 0\n\tglobal_load_lds_dwordx4 %1, off\n\ts_mov_b32 m0, %0":"=&s"(keep):"v"(gsrc),"s"(lds_dst):"memory");}
__device__ __forceinline__ float max3f(float a,float b,float c){float r;asm("v_max3_f32 %0, %1, %2, %3":"=v"(r):"v"(a),"v"(b),"v"(c));return r;}
__device__ __forceinline__ float max2f(float a,float b){float r;asm("v_max_f32_e32 %0, %1, %2":"=v"(r):"v"(a),"v"(b));return r;}
__device__ __forceinline__ float fadd_s(float a,float b){float r;asm("v_add_f32_e32 %0, %1, %2":"=v"(r):"v"(a),"v"(b));return r;}
__device__ __forceinline__ float fsub_s(float a,float b){float r;asm("v_sub_f32_e32 %0, %1, %2":"=v"(r):"v"(a),"v"(b));return r;}
typedef float f32x2_t __attribute__((ext_vector_type(2))); typedef __bf16 bf16x2_t __attribute__((ext_vector_type(2)));
__device__ __forceinline__ unsigned cvtpk_s(float lo,float hi){f32x2_t v={lo,hi};bf16x2_t b=__builtin_convertvector(v,bf16x2_t);return __builtin_bit_cast(unsigned,b);}
#define WAIT_BAR(N) asm volatile("s_waitcnt vmcnt(" #N ") lgkmcnt(0)\n\ts_barrier":::"memory")

typedef __attribute__((address_space(3))) const char* lds_cptr;
__device__ __forceinline__ void qkt(f32x16&p0,f32x16&p1,lds_cptr Kslot,const bf16x8*qr,int r32,int hi){
  const lds_cptr kb=Kslot+hi*1024+r32*16;
  #pragma unroll
  for(int d0=0;d0<4;++d0){
    const bf16x8 b0=*(const __attribute__((address_space(3))) bf16x8*)(kb+d0*2048);
    const bf16x8 b1=*(const __attribute__((address_space(3))) bf16x8*)(kb+d0*2048+512);
    p0=__builtin_amdgcn_mfma_f32_32x32x16_bf16(b0,qr[d0],p0,0,0,0);p1=__builtin_amdgcn_mfma_f32_32x32x16_bf16(b1,qr[d0],p1,0,0,0);}
}
typedef short v4i16_t __attribute__((ext_vector_type(4)));
__device__ __forceinline__ void kload8(bf16x8*kf,lds_cptr kp){
  kf[0]=*(const __attribute__((address_space(3))) bf16x8*)(kp);      kf[1]=*(const __attribute__((address_space(3))) bf16x8*)(kp+512);
  kf[2]=*(const __attribute__((address_space(3))) bf16x8*)(kp+2048); kf[3]=*(const __attribute__((address_space(3))) bf16x8*)(kp+2560);
  kf[4]=*(const __attribute__((address_space(3))) bf16x8*)(kp+4096); kf[5]=*(const __attribute__((address_space(3))) bf16x8*)(kp+4608);
  kf[6]=*(const __attribute__((address_space(3))) bf16x8*)(kp+6144); kf[7]=*(const __attribute__((address_space(3))) bf16x8*)(kp+6656);
}
__device__ __forceinline__ void kload2(bf16x8*kf,lds_cptr kp,int j){ kf[2*j]=*(const __attribute__((address_space(3))) bf16x8*)(kp+j*2048); kf[2*j+1]=*(const __attribute__((address_space(3))) bf16x8*)(kp+j*2048+512); }
__device__ __forceinline__ s16x4 vtr(lds_cptr p){ return __builtin_bit_cast(s16x4,__builtin_amdgcn_ds_read_tr16_b64_v4i16((__attribute__((address_space(3))) v4i16_t*)p)); }
__device__ __forceinline__ float rowmax(const f32x16&p0,const f32x16&p1){
  float a=max3f(p0[0],p0[1],p1[0]),b=max3f(p0[2],p0[3],p1[1]);a=max3f(a,p1[2],p1[3]);
  #pragma unroll
  for(int r=4;r<16;r+=4){a=max3f(a,p0[r],p0[r+1]);b=max3f(b,p0[r+2],p0[r+3]);a=max3f(a,p1[r],p1[r+1]);b=max3f(b,p1[r+2],p1[r+3]);}
  const float m=max2f(a,b);
  auto rr=__builtin_amdgcn_permlane32_swap(__float_as_uint(m),__float_as_uint(m),false,false);
  return max2f(__uint_as_float(rr[0]),__uint_as_float(rr[1]));
}
__device__ __forceinline__ void pv(f32x16*o,int vb,bf16x8 pa0,bf16x8 pa1,bf16x8 pa2,bf16x8 pa3){
  #pragma unroll
  for(int d0=0;d0<2;++d0){s16x4 lo[4],hi[4];
    #pragma unroll
    for(int ks=0;ks<4;++ks){
      asm volatile("ds_read_b64_tr_b16 %0,%1 offset:%c2":"=&v"(lo[ks]):"v"(vb),"i"(d0*4096+ks*1024):"memory");
      asm volatile("ds_read_b64_tr_b16 %0,%1 offset:%c2":"=&v"(hi[ks]):"v"(vb),"i"(d0*4096+ks*1024+512):"memory");}
    asm volatile("s_waitcnt lgkmcnt(0)":::"memory");SBAR();
    #define PK(k) (bf16x8){lo[k][0],lo[k][1],lo[k][2],lo[k][3],hi[k][0],hi[k][1],hi[k][2],hi[k][3]}
    o[d0]=__builtin_amdgcn_mfma_f32_32x32x16_bf16(pa0,PK(0),o[d0],0,0,0);
    o[d0]=__builtin_amdgcn_mfma_f32_32x32x16_bf16(pa1,PK(1),o[d0],0,0,0);
    o[d0]=__builtin_amdgcn_mfma_f32_32x32x16_bf16(pa2,PK(2),o[d0],0,0,0);
    o[d0]=__builtin_amdgcn_mfma_f32_32x32x16_bf16(pa3,PK(3),o[d0],0,0,0);
    #undef PK
  }
}

template<int THRL> __device__ __forceinline__ void fox_unit(const int b,const int qb,const bf16_t*qT,const bf16_t*__restrict__ kT,const bf16_t*__restrict__ vT,bf16_t*Oh,LAS unsigned char*shm,const LAS float*biasf){
  const int tid=fresh_tid(),lane=tid&63,r32=lane&31,hi=lane>>5; const int wid=__builtin_amdgcn_readfirstlane(tid>>6);
  const size_t tok0=(size_t)b*SEQ; const int q0=qb*QB;
  const bf16_t*qsrc=qT+(tok0+q0+wid*QBLK+r32)*32+8*hi;
  const unsigned lds0=(unsigned)(uintptr_t)shm;
  LAS float*wsf=(LAS float*)(shm+LDS_WS)+wid*64;
  const bf16_t*ksrc=kT+(tok0+lane+(size_t)(wid>>2)*SEQ)*32+(wid&3)*8;
  const bf16_t*vsrc=vT+(tok0+16*(wid&3)+(lane>>2)+(size_t)(wid>>2)*SEQ)*32+(lane&3)*8;
  const unsigned kdst=lds0+LDS_K+wid*1024, vdst=lds0+LDS_V+wid*1024;
  #define DMA_K(t,slot) glds16(ksrc+(size_t)(t)*KVBLK*32,(unsigned)__builtin_amdgcn_readfirstlane(kdst+(slot)))
  #define DMA_V(t,slot) glds16(vsrc+(size_t)(t)*KVBLK*32,(unsigned)__builtin_amdgcn_readfirstlane(vdst+(slot)))
  const int vb0=(int)(lds0+LDS_V)+((lane>>4)&1)*32+(lane&3)*8+(4*hi+((lane&15)>>2))*64;
  bf16x8 kf[8];
  const lds_cptr shm3=(lds_cptr)shm; const lds_cptr Kbase=shm3+LDS_K; const lds_cptr kp0=shm3+LDS_K+hi*1024+r32*16; const lds_cptr vp0=shm3+LDS_V+((lane>>4)&1)*32+(lane&3)*8+(4*hi+((lane&15)>>2))*64;
  const int NT=(q0+QB)/KVBLK;
  DMA_K(0,0);DMA_V(0,0);DMA_K(1,SLOTB);
  bf16x8 qr[4];
  #pragma unroll
  for(int d0=0;d0<4;++d0)qr[d0]=*reinterpret_cast<const bf16x8*>(qsrc+(size_t)(d0>>1)*SEQ*32+16*(d0&1));
  float mhat=0.f,l_reg=0.f;f32x16 o[2];o[0]=f32x16{};o[1]=f32x16{};
  const int qrel=wid*QBLK+r32;
  #define CMASK(P0,P1,t) do{int jb_=(t)-(NT-4); if(jb_>=0)cmask(P0,P1,jb_,qrel,hi);}while(0)
  bool resc=false;
  #define START(P0,P1) do{ const float rm=rowmax(P0,P1); resc=false; mhat=rm; \
    _Pragma("unroll") for(int r=0;r<16;++r)P0[r]=__builtin_amdgcn_exp2f(P0[r]-mhat); }while(0)
  #define RESC() do{ if(resc){ asm volatile("s_waitcnt lgkmcnt(0)":::"memory"); \
      _Pragma("unroll") for(int d_=0;d_<2;++d_) _Pragma("unroll") for(int r=0;r<16;++r)o[d_][r]*=wsf[crow(r,hi)]; } }while(0)
  f32x16 pA0,pA1,pB0,pB1;
  int sl_prev=0,sl_cur=0,sl_next=SLOTB;
  #define ROT() do{sl_prev=sl_cur;sl_cur=sl_next;sl_next=(sl_next==(NSLOT-1)*SLOTB)?0:sl_next+SLOTB;}while(0)
  DMA_K(2,2*SLOTB);
  WAIT_BAR(3);
  { const LAS float*bp0_=biasf+4*hi; _Pragma("unroll") for(int g=0;g<4;++g){ const f32x4 x0_=*(const LAS f32x4*)(bp0_+8*g), x1_=*(const LAS f32x4*)(bp0_+32+8*g); _Pragma("unroll") for(int j=0;j<4;++j){pA0[4*g+j]=x0_[j];pA1[4*g+j]=x1_[j];} } }
  qkt(pA0,pA1,Kbase,qr,r32,hi);asm volatile("s_nop 15\n\ts_nop 7":"+v"(pA0),"+v"(pA1));CMASK(pA0,pA1,0);
  START(pA0,pA1);
  _Pragma("unroll") for(int r=0;r<16;++r)pA1[r]=__builtin_amdgcn_exp2f(pA1[r]-mhat);
  WAIT_BAR(0);
  DMA_K(3,0);DMA_V(1,SLOTB);
  ROT();
  kload8(kf,kp0+sl_cur);
  { const LAS float*bp1_=biasf+KVBLK+4*hi; _Pragma("unroll") for(int g=0;g<4;++g){ const f32x4 x0_=*(const LAS f32x4*)(bp1_+8*g), x1_=*(const LAS f32x4*)(bp1_+32+8*g); _Pragma("unroll") for(int j=0;j<4;++j){pB0[4*g+j]=x0_[j];pB1[4*g+j]=x1_[j];} } }
  WAIT_BAR(2);
  s16x4 vlo[8],vhi[8]; u32x4 pw0,pw1,pw2,pw3;
  #define PKW(P,B) cvtpk_s(P[B],P[B+1])
  #define PAF(k) __builtin_bit_cast(bf16x8,pw##k)
  #define VFR(i) (bf16x8){vlo[i][0],vlo[i][1],vlo[i][2],vlo[i][3],vhi[i][0],vhi[i][1],vhi[i][2],vhi[i][3]}
  #define PIN(x) asm volatile("":"+v"(x))
  #define MX3(a,b,c) __builtin_fmaxf(__builtin_fmaxf((a),(b)),(c))
  #define GAPA(MF,A0,A1,A2,A3,W0,W1,PW) do{ MF; sacc+=A0; sacc+=A1; sacc+=A2; sacc+=A3; PIN(sacc); W0; W1; PIN(PW); SBAR(); }while(0)
  #define EX(v) __builtin_amdgcn_exp2f(v)
  #define GAPB(MF,X,B) do{ MF; X[B]=EX(X[B]-mhat); X[B+1]=EX(X[B+1]-mhat); X[B+2]=EX(X[B+2]-mhat); X[B+3]=EX(X[B+3]-mhat); PIN(X); SBAR(); }while(0)
  #define VRD(i) do{ vlo[i]=vtr(vp_+(((i)>>2)*4096+((i)&3)*1024)); vhi[i]=vtr(vp_+(((i)>>2)*4096+((i)&3)*1024+512)); }while(0)
  #define KRD(G,j) do{ if(G){ kload2(kf,kp0+sl_next,j); SBAR(); } }while(0)
  #define BRD1(P,O_,g) do{ const f32x4 x_=*(const LAS f32x4*)(bp_+(O_)+8*(g)); P[4*(g)]=x_[0];P[4*(g)+1]=x_[1];P[4*(g)+2]=x_[2];P[4*(g)+3]=x_[3]; }while(0)
  #define BRD(G,P,O_,g) do{ if(G){ BRD1(P,O_,g); BRD1(P,O_,(g)+1); SBAR(); } }while(0)
  #define STEP(C0,C1,P0,P1,t,GK,GV,GL) do{ SBAR(); \
    const lds_cptr vp_=vp0+sl_prev; \
    VRD(0); SBAR(); float sacc=(P0[0]+P0[1]); \
    GAPA(C0=__builtin_amdgcn_mfma_f32_32x32x16_bf16(kf[0],qr[0],C0,0,0,0), P0[2],P0[3],P0[4],P0[5],     pw0[0]=PKW(P0,0), pw0[1]=PKW(P0,2), pw0); \
    VRD(4); SBAR(); GAPA(C1=__builtin_amdgcn_mfma_f32_32x32x16_bf16(kf[1],qr[0],C1,0,0,0), P0[6],P0[7],P0[8],P0[9],     pw0[2]=PKW(P0,4), pw0[3]=PKW(P0,6), pw0); \
    VRD(1); SBAR(); GAPA(C0=__builtin_amdgcn_mfma_f32_32x32x16_bf16(kf[2],qr[1],C0,0,0,0),   P0[10],P0[11],P0[12],P0[13], pw1[0]=PKW(P0,8), pw1[1]=PKW(P0,10), pw1); \
    VRD(5); SBAR(); GAPA(C1=__builtin_amdgcn_mfma_f32_32x32x16_bf16(kf[3],qr[1],C1,0,0,0),   P0[14],P0[15],P1[0],P1[1],   pw1[2]=PKW(P0,12),pw1[3]=PKW(P0,14), pw1); \
    VRD(2); SBAR(); GAPA(C0=__builtin_amdgcn_mfma_f32_32x32x16_bf16(kf[4],qr[2],C0,0,0,0),   P1[2],P1[3],P1[4],P1[5],     pw2[0]=PKW(P1,0), pw2[1]=PKW(P1,2), pw2); \
    VRD(6); SBAR(); GAPA(C1=__builtin_amdgcn_mfma_f32_32x32x16_bf16(kf[5],qr[2],C1,0,0,0),   P1[6],P1[7],P1[8],P1[9],     pw2[2]=PKW(P1,4), pw2[3]=PKW(P1,6), pw2); \
    VRD(3); SBAR(); GAPA(C0=__builtin_amdgcn_mfma_f32_32x32x16_bf16(kf[6],qr[3],C0,0,0,0),   P1[10],P1[11],P1[12],P1[13], pw3[0]=PKW(P1,8), pw3[1]=PKW(P1,10), pw3); \
    VRD(7); SBAR(); GAPA(C1=__builtin_amdgcn_mfma_f32_32x32x16_bf16(kf[7],qr[3],C1,0,0,0),   P1[14],P1[15],0.f,0.f,       pw3[2]=PKW(P1,12),pw3[3]=PKW(P1,14), pw3); \
    l_reg+=sacc; \
    if(GK){DMA_K((t)+3,sl_cur);} if(GV){DMA_V((t)+1,sl_next);} \
    CMASK(C0,C1,t); \
    { float a=MX3(C0[0],C0[1],C1[0]),b=MX3(C0[2],C0[3],C1[1]); a=MX3(a,C1[2],C1[3]); \
      _Pragma("unroll") for(int r=4;r<16;r+=4){a=MX3(a,C0[r],C0[r+1]);b=MX3(b,C0[r+2],C0[r+3]);a=MX3(a,C1[r],C1[r+1]);b=MX3(b,C1[r+2],C1[r+3]);} \
      float rm=__builtin_fmaxf(a,b); { auto rr=__builtin_amdgcn_permlane32_swap(__float_as_uint(rm),__float_as_uint(rm),false,false); rm=__builtin_fmaxf(__uint_as_float(rr[0]),__uint_as_float(rr[1])); } \
      resc=false; \
      if(__builtin_expect(__builtin_amdgcn_ballot_w64(rm-mhat>(float)THRL)!=0ull,0)){ const float dl=__builtin_fmaxf(rm-mhat,0.f); mhat+=dl; \
        const float f=__builtin_amdgcn_exp2f(-dl); l_reg*=f; if(hi==0)wsf[r32]=f; resc=true; } } \
    SBAR(); \
    const LAS float*bp_=biasf+((t)+1)*KVBLK+4*hi; \
    BRD(GL,P0,0,0); GAPB(o[0]=__builtin_amdgcn_mfma_f32_32x32x16_bf16(PAF(0),VFR(0),o[0],0,0,0), C0,0); \
    BRD(GL,P0,0,2); GAPB(o[1]=__builtin_amdgcn_mfma_f32_32x32x16_bf16(PAF(0),VFR(4),o[1],0,0,0), C0,4); \
    KRD(GL,0); GAPB(o[0]=__builtin_amdgcn_mfma_f32_32x32x16_bf16(PAF(1),VFR(1),o[0],0,0,0), C0,8); \
    KRD(GL,1); GAPB(o[1]=__builtin_amdgcn_mfma_f32_32x32x16_bf16(PAF(1),VFR(5),o[1],0,0,0), C0,12); \
    KRD(GL,2); GAPB(o[0]=__builtin_amdgcn_mfma_f32_32x32x16_bf16(PAF(2),VFR(2),o[0],0,0,0), C1,0); \
    KRD(GL,3); GAPB(o[1]=__builtin_amdgcn_mfma_f32_32x32x16_bf16(PAF(2),VFR(6),o[1],0,0,0), C1,4); \
    BRD(GL,P1,32,0); GAPB(o[0]=__builtin_amdgcn_mfma_f32_32x32x16_bf16(PAF(3),VFR(3),o[0],0,0,0), C1,8); \
    BRD(GL,P1,32,2); GAPB(o[1]=__builtin_amdgcn_mfma_f32_32x32x16_bf16(PAF(3),VFR(7),o[1],0,0,0), C1,12); \
    }while(0)
  int t=1;
  #undef CMASK
  #define CMASK(P0,P1,t) do{}while(0)
  for(;t+5<NT;t+=2){
    STEP(pB0,pB1,pA0,pA1,t,true,true,true);     WAIT_BAR(2); RESC(); ROT();
    STEP(pA0,pA1,pB0,pB1,t+1,true,true,true);   WAIT_BAR(2); RESC(); ROT();
  }
  #undef CMASK
  #define CMASK(P0,P1,t) do{int jb_=(t)-(NT-4); if(jb_>=0)cmask(P0,P1,jb_,qrel,hi);}while(0)
  #define ENDW(tt) do{ if((tt)+3<NT){WAIT_BAR(2);} else if((tt)+2<NT){WAIT_BAR(1);} else {WAIT_BAR(0);} }while(0)
  for(;t+1<NT;t+=2){
    STEP(pB0,pB1,pA0,pA1,t,(t+3<NT),(t+1<NT),(t+1<NT));       ENDW(t);   RESC(); ROT();
    STEP(pA0,pA1,pB0,pB1,t+1,(t+4<NT),(t+2<NT),(t+2<NT));     ENDW(t+1); RESC(); ROT();
  }
  STEP(pB0,pB1,pA0,pA1,NT-1,false,false,false); RESC();
  { float sacc=pB0[0]+pB0[1]; _Pragma("unroll") for(int r=2;r<16;++r)sacc+=pB0[r]; _Pragma("unroll") for(int r=0;r<16;++r)sacc+=pB1[r]; l_reg+=sacc;
    pw0=(u32x4){PKW(pB0,0),PKW(pB0,2),PKW(pB0,4),PKW(pB0,6)};pw1=(u32x4){PKW(pB0,8),PKW(pB0,10),PKW(pB0,12),PKW(pB0,14)};pw2=(u32x4){PKW(pB1,0),PKW(pB1,2),PKW(pB1,4),PKW(pB1,6)};pw3=(u32x4){PKW(pB1,8),PKW(pB1,10),PKW(pB1,12),PKW(pB1,14)};
    SBAR(); pv(o,vb0+sl_cur,PAF(0),PAF(1),PAF(2),PAF(3)); }
  #undef PKW
  #undef PAF
  #undef VFR
  #undef PIN
  #undef MX3
  #undef GAPA
  #undef GAPB
  #undef EX
  #undef VRD
  #undef KRD
  #undef BRD
  #undef BRD1
  #undef STEP
  #undef ENDW
  {auto rr=__builtin_amdgcn_permlane32_swap(__float_as_uint(l_reg),__float_as_uint(l_reg),false,false);l_reg=__uint_as_float(rr[0])+__uint_as_float(rr[1]);}
  if(hi==0)wsf[32+r32]=l_reg;asm volatile("s_waitcnt lgkmcnt(0)":::"memory");
  float rli[16];
  #pragma unroll
  for(int r=0;r<16;++r)rli[r]=__builtin_amdgcn_rcpf(wsf[32+crow(r,hi)]);
  bf16_t*Ow=Oh+(tok0+q0+wid*QBLK)*(size_t)1024;
  { LAS bf16_t*stg=(LAS bf16_t*)(shm+LDS_OST)+wid*2048;
    #pragma unroll
    for(int r=0;r<16;++r){const int orow=crow(r,hi);
      #pragma unroll
      for(int d0=0;d0<2;++d0)stg[orow*64+d0*32+r32]=(bf16_t)cvt_pk_bf16(o[d0][r]*rli[r],0.f);}
    asm volatile("s_waitcnt lgkmcnt(0)":::"memory");
    #pragma unroll
    for(int i=0;i<4;++i){const int row=i*8+(lane>>3),ch=lane&7; const u32x4 v=*(const LAS u32x4*)(stg+row*64+ch*8); *(u32x4*)(Ow+(size_t)row*1024+ch*8)=v;} }
  asm volatile("s_waitcnt lgkmcnt(0)\n\ts_barrier":::"memory");
  #undef DMA_K
  #undef DMA_V
  #undef CMASK
  #undef START
  #undef RESC
  #undef ROT
}
#undef SBAR
#undef WAIT_BAR
}
static_assert(fx::LDS_BYTES <= BIAS_OFF, "forgetting-attention LDS map");
}

struct Args {
    const float *x, *c, *w_ada, *b_ada, *w_in, *b_forget, *b_gate, *w_br_fox, *w_br_dil, *w_o, *ln_g, *ln_b, *w_router, *router_bias,
                *w_eg, *w_eu, *w_ed, *w_sg, *w_su, *w_sd;
    float* out; unsigned char* ws;
    int g0, g1, sync, pad;
};
typedef const __attribute__((address_space(4))) Args CArgs;
#define KARGS() ({ CArgs* p_ = (CArgs*)__builtin_amdgcn_kernarg_segment_ptr(); asm volatile("" : "+s"(p_)); p_; })

DI int rc(int lane) { return (lane >> 4) * 256 + ((lane >> 2) & 3) * 32 + (lane & 3) * 8; }
DI void row_load_f32(const float* p, int lane, float (&v)[16]) {
#pragma unroll
    for (int j = 0; j < 2; ++j) { const f32x4 a = *(const f32x4*)(p + rc(lane) + 128 * j), b = *(const f32x4*)(p + rc(lane) + 128 * j + 4);
#pragma unroll
        for (int i = 0; i < 4; ++i) { v[j * 8 + i] = a[i]; v[j * 8 + 4 + i] = b[i]; } }
}
DI void row_store_f32(float* p, int lane, const float (&v)[16]) {
#pragma unroll
    for (int j = 0; j < 2; ++j) { *(f32x4*)(p + rc(lane) + 128 * j) = (f32x4){v[j * 8], v[j * 8 + 1], v[j * 8 + 2], v[j * 8 + 3]}; *(f32x4*)(p + rc(lane) + 128 * j + 4) = (f32x4){v[j * 8 + 4], v[j * 8 + 5], v[j * 8 + 6], v[j * 8 + 7]}; }
}
DI void row_store_bf16(bf16_t* p, int lane, const float (&v)[16]) {
#pragma unroll
    for (int j = 0; j < 2; ++j) { u32x4 w; w.x = cvt_pk_bf16(v[j * 8], v[j * 8 + 1]); w.y = cvt_pk_bf16(v[j * 8 + 2], v[j * 8 + 3]); w.z = cvt_pk_bf16(v[j * 8 + 4], v[j * 8 + 5]); w.w = cvt_pk_bf16(v[j * 8 + 6], v[j * 8 + 7]);
        *(u32x4*)(p + rc(lane) + 128 * j) = w; }
}
DI void row_load_bf16(const bf16_t* p, int lane, float (&v)[16]) {
#pragma unroll
    for (int j = 0; j < 2; ++j) { const u32x4 w = *(const u32x4*)(p + rc(lane) + 128 * j);
        v[j * 8 + 0] = bf_lo(w.x); v[j * 8 + 1] = bf_hi(w.x); v[j * 8 + 2] = bf_lo(w.y); v[j * 8 + 3] = bf_hi(w.y); v[j * 8 + 4] = bf_lo(w.z); v[j * 8 + 5] = bf_hi(w.z); v[j * 8 + 6] = bf_lo(w.w); v[j * 8 + 7] = bf_hi(w.w); }
}
DI void row_load_f32_nt(const float* p, int lane, float (&v)[16]) {
#pragma unroll
    for (int j = 0; j < 2; ++j) { const f32x4 a = __builtin_nontemporal_load((const f32x4*)(p + rc(lane) + 128 * j)), b = __builtin_nontemporal_load((const f32x4*)(p + rc(lane) + 128 * j + 4));
#pragma unroll
        for (int i = 0; i < 4; ++i) { v[j * 8 + i] = a[i]; v[j * 8 + 4 + i] = b[i]; } }
}
DI void row_store_f32_nt(float* p, int lane, const float (&v)[16]) {
#pragma unroll
    for (int j = 0; j < 2; ++j) { __builtin_nontemporal_store((f32x4){v[j * 8], v[j * 8 + 1], v[j * 8 + 2], v[j * 8 + 3]}, (f32x4*)(p + rc(lane) + 128 * j)); __builtin_nontemporal_store((f32x4){v[j * 8 + 4], v[j * 8 + 5], v[j * 8 + 6], v[j * 8 + 7]}, (f32x4*)(p + rc(lane) + 128 * j + 4)); }
}
DI void row_load_bf16_nt(const bf16_t* p, int lane, float (&v)[16]) {
#pragma unroll
    for (int j = 0; j < 2; ++j) { const u32x4 w = __builtin_nontemporal_load((const u32x4*)(p + rc(lane) + 128 * j));
        v[j * 8 + 0] = bf_lo(w.x); v[j * 8 + 1] = bf_hi(w.x); v[j * 8 + 2] = bf_lo(w.y); v[j * 8 + 3] = bf_hi(w.y); v[j * 8 + 4] = bf_lo(w.z); v[j * 8 + 5] = bf_hi(w.z); v[j * 8 + 6] = bf_lo(w.w); v[j * 8 + 7] = bf_hi(w.w); }
}
DI void row_layernorm(float (&v)[16], const float (&g)[16], const float (&bb)[16]) {
    float s = 0.f;
#pragma unroll
    for (int i = 0; i < 16; ++i) s += v[i];
    const float mean = wave_sum(s) * (1.0f / D);
    float q = 0.f;
#pragma unroll
    for (int i = 0; i < 16; ++i) { v[i] -= mean; q += v[i] * v[i]; }
    const float rstd = rsqrtf(wave_sum(q) * (1.0f / D) + LN_EPS);
#pragma unroll
    for (int i = 0; i < 16; ++i) v[i] = v[i] * rstd * g[i] + bb[i];
}
DI void emit_u_logf(const float (&xv)[16], const float* modl, const LAS float* wff, const float* bforget, bf16_t* urow, float* lfrow, int lane_in) {
    int lane = lane_in; asm volatile("" : "+v"(lane));
    float sh[16], sc[16], uf[16];
    row_load_f32(modl, lane, sh); row_load_f32(modl + 1024, lane, sc);
#pragma unroll
    for (int i = 0; i < 16; ++i) uf[i] = xv[i] * (1.0f + sc[i]) + sh[i];
    row_store_bf16(urow, lane, uf);
    float p[8];
#pragma unroll
    for (int hd = 0; hd < 8; ++hd) p[hd] = 0.f;
#pragma unroll
    for (int j = 0; j < 2; ++j)
#pragma unroll
        for (int i = 0; i < 8; ++i) { const int k = rc(lane) + 128 * j + i; const f32x4 w0 = *(const LAS f32x4*)(wff + k * 8), w1 = *(const LAS f32x4*)(wff + k * 8 + 4);
            const float u = uf[j * 8 + i];
            p[0] += u * w0[0]; p[1] += u * w0[1]; p[2] += u * w0[2]; p[3] += u * w0[3]; p[4] += u * w1[0]; p[5] += u * w1[1]; p[6] += u * w1[2]; p[7] += u * w1[3]; }
#pragma unroll
    for (int hd = 0; hd < 8; ++hd) p[hd] = wave_sum(p[hd]);
    float mine = p[0];
    mine = (lane == 1) ? p[1] : mine; mine = (lane == 2) ? p[2] : mine; mine = (lane == 3) ? p[3] : mine; mine = (lane == 4) ? p[4] : mine;
    mine = (lane == 5) ? p[5] : mine; mine = (lane == 6) ? p[6] : mine; mine = (lane == 7) ? p[7] : mine;
    if (lane < 8) { const float xx = mine + bforget[lane]; lfrow[lane] = fminf(xx, 0.f) - 0.6931471805599453f * __builtin_amdgcn_logf(1.0f + __builtin_amdgcn_exp2f(-fabsf(xx) * LOG2E)); }
}
DI void load_wff(const float* w_in_l, LAS float* wff) {
    for (int idx = fresh_tid(); idx < 1024 * 8; idx += 512) wff[idx] = w_in_l[(size_t)(idx >> 3) * INCOLS + 1536 + (idx & 7)];
}

DI void phase_pre(CArgs& a, LAS unsigned char* ring) {
    float* mod = (float*)(a.ws + WS_MOD); float* cosT = (float*)(a.ws + WS_ROPE); float* sinT = cosT + 2048 * 32;
    LAS float* cs = (LAS float*)ring;
    const int tid = fresh_tid();
    for (int unit = blockIdx.x; unit < 192 + 128; unit += gridDim.x) {
        if (unit < 192) {
            const int l = unit / 48, rem = unit % 48, nb = rem / 4, bg = rem % 4;
            __syncthreads();
            for (int idx = tid; idx < 8192; idx += 512) { const int k = idx >> 3, j = idx & 7; const float cv = a.c[(bg * 8 + j) * D + k]; cs[idx] = cv * fast_sigmoid(cv); }
            __syncthreads();
            const int n = nb * 512 + tid;
            float acc[8];
#pragma unroll
            for (int j = 0; j < 8; ++j) acc[j] = 0.f;
            const float* wp = a.w_ada + (size_t)l * D * 6144 + n;
#pragma unroll 16
            for (int k = 0; k < D; ++k) { const float w = wp[(size_t)k * 6144]; const f32x4 c0 = *(const LAS f32x4*)(cs + k * 8), c1 = *(const LAS f32x4*)(cs + k * 8 + 4);
                acc[0] += w * c0[0]; acc[1] += w * c0[1]; acc[2] += w * c0[2]; acc[3] += w * c0[3]; acc[4] += w * c1[0]; acc[5] += w * c1[1]; acc[6] += w * c1[2]; acc[7] += w * c1[3]; }
            const float bb = a.b_ada[l * 6144 + n];
#pragma unroll
            for (int j = 0; j < 8; ++j) mod[(size_t)(l * 32 + bg * 8 + j) * 6144 + n] = acc[j] + bb;
        } else {
            const int idx = (unit - 192) * 512 + tid;
            const int pos = idx >> 5, i = idx & 31;
            const float invf = powf(10000.0f, -(float)i * (2.0f / 64.0f));
            const float ang = (float)pos * invf;
            cosT[idx] = cosf(ang); sinT[idx] = sinf(ang);
        }
    }
    __syncthreads();
}

DI void phase_w(CArgs& a, LAS unsigned char* ring, const int l) {
    LAS float* tile = (LAS float*)ring;
    LAS float* wff = (LAS float*)(ring + 69632);
    unsigned char* W = a.ws + WS_W;
    const int tid = fresh_tid();
    for (int t = blockIdx.x; t < 3584; t += gridDim.x) {
        const float* src; int ld, K, n0, k0, kd = 0; bf16_t* dst; int kind; int e = 0;
        if (t < 320) { kind = 0; src = a.w_in + (size_t)l * D * INCOLS; ld = INCOLS; K = D; n0 = (t % 80) * 64; k0 = (t / 80) * 256; dst = (bf16_t*)(W + W_IN); }
        else if (t < 352) { const int q = t - 320; kind = 1; src = a.w_br_fox + (size_t)l * 512 * D; ld = D; K = D; n0 = (q / 2) * 64; k0 = (q % 2) * 256; dst = (bf16_t*)(W + W_BF); }
        else if (t < 384) { const int q = t - 352; kind = 1; src = a.w_br_dil + (size_t)l * 512 * D; ld = D; K = D; kd = 512; n0 = (q / 2) * 64; k0 = (q % 2) * 256; dst = (bf16_t*)(W + W_BF); }
        else if (t < 448) { const int q = t - 384; kind = 1; src = a.w_o + (size_t)l * D * D; ld = D; K = D; n0 = (q % 16) * 64; k0 = (q / 16) * 256; dst = (bf16_t*)(W + W_O); }
        else if (t < 464) { const int q = t - 448; kind = 2; src = a.w_router + (size_t)l * D * NE; ld = NE; K = D; n0 = (q / 4) * 64; k0 = (q % 4) * 256; dst = (bf16_t*)(W + W_R); }
        else if (t < 464 + 2080) { const int q = t - 464; e = q / 32; const int qq = q % 32; kind = 3; ld = 256; K = D; n0 = (qq % 8) * 64; k0 = (qq / 8) * 256; dst = (bf16_t*)(W + W_GU) + (size_t)e * 512 * D;
            const int isup = (n0 >> 7) & 1;
            src = (e < NE) ? ((isup ? a.w_eu : a.w_eg) + (size_t)(l * NE + e) * D * 256) : ((isup ? a.w_su : a.w_sg) + (size_t)l * D * 256); }
        else { const int q = t - 464 - 2080; e = q / 16; const int qq = q % 16; kind = 1; ld = D; K = 256; n0 = qq * 64; k0 = 0; dst = (bf16_t*)(W + W_DN) + (size_t)e * D * 256;
            src = (e < NE) ? (a.w_ed + (size_t)(l * NE + e) * 256 * D) : (a.w_sd + (size_t)l * 256 * D); }
        const int nl = (tid & 15) * 4; const int j = n0 + nl; int scol = j; bool valid = true;
        if (kind == 0) {
            if (j < 1536) scol = j;
            else if (j < 2560) { const int cc = j - 1536, hd = cc >> 6, p = cc & 63, g = p >> 3, jj = p & 7; const int d = (jj < 4) ? (4 * g + jj) : (32 + 4 * g + (jj - 4)); scol = 1544 + hd * 64 + d; }
            else scol = j + 8;
        } else if (kind == 2) { valid = (j < NE); scol = valid ? j : 0; }
        else if (kind == 3) { const int pnn = j >> 8, w = j & 255; scol = 128 * pnn + (w & 127); }
        __syncthreads();
        { const float* sp = src + (size_t)(k0 + (tid >> 4)) * ld + scol;
#pragma unroll
          for (int i = 0; i < 8; ++i) { const int k = (tid >> 4) + 32 * i; const f32x4 v = valid ? __builtin_nontemporal_load((const f32x4*)(sp + (size_t)(32 * i) * ld)) : (f32x4){0.f, 0.f, 0.f, 0.f};
              tile[k * 65 + nl] = v[0]; tile[k * 65 + nl + 1] = v[1]; tile[k * 65 + nl + 2] = v[2]; tile[k * 65 + nl + 3] = v[3]; } }
        __syncthreads();
        { const int n2 = tid >> 3;
#pragma unroll
          for (int c4 = 0; c4 < 4; ++c4) { const int ks = (tid & 7) * 8 + 64 * c4; float v[8];
#pragma unroll
            for (int i = 0; i < 8; ++i) v[i] = tile[(ks + i) * 65 + n2];
            u32x4 w; w.x = cvt_pk_bf16(v[0], v[1]); w.y = cvt_pk_bf16(v[2], v[3]); w.z = cvt_pk_bf16(v[4], v[5]); w.w = cvt_pk_bf16(v[6], v[7]);
            __builtin_nontemporal_store(w, (u32x4*)(dst + (size_t)(n0 + n2) * K + kd + k0 + ks)); } }
    }
    if (l == 0) {
        __syncthreads();
        load_wff(a.w_in, wff);
        __syncthreads();
        const int wid = tid >> 6, lane = tid & 63;
        const float* mod = (const float*)(a.ws + WS_MOD);
        bf16_t* U = (bf16_t*)(a.ws + WS_U); float* LF = (float*)(a.ws + WS_LOGF);
        for (int row = blockIdx.x * 8 + wid; row < NTOK; row += gridDim.x * 8) {
            float xv[16]; row_load_f32_nt(a.x + (size_t)row * D, lane, xv);
            emit_u_logf(xv, mod + (size_t)(0 * 32 + (row >> 11)) * 6144, wff, a.b_forget, U + (size_t)row * D, LF + (size_t)row * 8, lane);
        }
    }
    __syncthreads();
}

DI void phase_ln1(CArgs& a, const int l, const bool dry) {
    const int tid = fresh_tid(), wid = tid >> 6, lane = tid & 63;
    const float* mod = (const float*)(a.ws + WS_MOD); bf16_t* U = (bf16_t*)(a.ws + WS_U); bf16_t* XB = (bf16_t*)(a.ws + WS_XB);
    float g[16], bb[16];
    row_load_f32(a.ln_g + (size_t)(l * 2 + 0) * D, lane, g); row_load_f32(a.ln_b + (size_t)(l * 2 + 0) * D, lane, bb);
    for (int row = blockIdx.x * 8 + wid; row < NTOK / 2; row += gridDim.x * 8) {
        float v[16], w[16]; row_load_bf16_nt(XB + (size_t)row * D, lane, v); row_load_bf16_nt(XB + (size_t)(row + NTOK / 2) * D, lane, w);
        {   const float* modl = mod + (size_t)(l * 32 + (row >> 11)) * 6144;
            float sh[16], sc[16]; row_load_f32(modl + 3072, lane, sh); row_load_f32(modl + 4096, lane, sc);
            row_layernorm(v, g, bb);
            row_store_bf16(XB + (size_t)row * D, lane, v);
#pragma unroll
            for (int i = 0; i < 16; ++i) v[i] = v[i] * (1.0f + sc[i]) + sh[i];
            row_store_bf16(U + (size_t)row * D, lane, v); }
        {   const int r2 = row + NTOK / 2;
            const float* modl = mod + (size_t)(l * 32 + (r2 >> 11)) * 6144;
            float sh[16], sc[16]; row_load_f32(modl + 3072, lane, sh); row_load_f32(modl + 4096, lane, sc);
            row_layernorm(w, g, bb);
            row_store_bf16(XB + (size_t)r2 * D, lane, w);
#pragma unroll
            for (int i = 0; i < 16; ++i) w[i] = w[i] * (1.0f + sc[i]) + sh[i];
            row_store_bf16(U + (size_t)r2 * D, lane, w); }
    }
}

DI void phase_route(CArgs& a, LAS unsigned char* lds, const int l, const bool dry) {
    LAS float* Ssc = (LAS float*)(lds + RING_OFF);
    LAS float* rb = (LAS float*)(lds + LM_RB);
    LAS int* lh = (LAS int*)(lds + LM_LH);
    const float* LG = (const float*)(a.ws + WS_LOGITS);
    int* EIDX = (int*)(a.ws + WS_EIDX); float* GW = (float*)(a.ws + WS_GW);
    unsigned* CNT = (unsigned*)(a.ws + WS_CTL) + CW_CNT + (dry ? 2048 : 0);
    const int tid = fresh_tid();
    if (tid < NE) rb[tid] = a.router_bias[l * NE + tid];
    for (int tb = blockIdx.x; tb < NTOK / 256; tb += gridDim.x) {
        __syncthreads();
        if (tid < 80) lh[tid] = 0;
#pragma unroll 4
        for (int i = 0; i < 32; ++i) { const int idx = tid + 512 * i; const int tk = idx >> 6, e = idx & 63; Ssc[tk * 65 + e] = fast_sigmoid(__builtin_nontemporal_load(LG + (size_t)tb * 256 * 64 + idx)); }
        __syncthreads();
        if (tid < 256) {
            const LAS float* S = Ssc + tid * 65;
            float gs[8];
#pragma unroll
            for (int g = 0; g < 8; ++g) { float m1 = -3.0e38f, m2 = -3.0e38f;
#pragma unroll
                for (int j = 0; j < 8; ++j) { const float v = S[8 * g + j] + rb[8 * g + j]; if (v > m1) { m2 = m1; m1 = v; } else if (v > m2) m2 = v; }
                gs[g] = m1 + m2; }
            unsigned gmask = 0;
#pragma unroll
            for (int g = 0; g < 8; ++g) { int rank = 0;
#pragma unroll
                for (int g2 = 0; g2 < 8; ++g2) rank += ((gs[g2] > gs[g]) || (gs[g2] == gs[g] && g2 < g)) ? 1 : 0;
                gmask |= (rank < 4) ? (1u << g) : 0u; }
            float vv[64];
#pragma unroll
            for (int e = 0; e < NE; ++e) vv[e] = ((gmask >> (e >> 3)) & 1u) ? (S[e] + rb[e]) : -3.0e38f;
            int idx[8]; float sc[8]; float ssum = 0.f;
#pragma unroll
            for (int k = 0; k < 8; ++k) {
                float mxv = vv[0];
#pragma unroll
                for (int e = 1; e < NE; ++e) mxv = fmaxf(mxv, vv[e]);
                int bi = 0;
#pragma unroll
                for (int e = NE - 1; e >= 0; --e) bi = (vv[e] == mxv) ? e : bi;
#pragma unroll
                for (int e = 0; e < NE; ++e) vv[e] = (e == bi) ? -3.0e38f : vv[e];
                idx[k] = bi; sc[k] = S[bi]; ssum += sc[k]; }
            const float rs = 2.5f / ssum;
            const size_t tok = (size_t)tb * 256 + tid;
            *(i32x4*)(EIDX + tok * 8) = (i32x4){idx[0], idx[1], idx[2], idx[3]}; *(i32x4*)(EIDX + tok * 8 + 4) = (i32x4){idx[4], idx[5], idx[6], idx[7]};
            *(f32x4*)(GW + tok * 8) = (f32x4){sc[0] * rs, sc[1] * rs, sc[2] * rs, sc[3] * rs}; *(f32x4*)(GW + tok * 8 + 4) = (f32x4){sc[4] * rs, sc[5] * rs, sc[6] * rs, sc[7] * rs};
#pragma unroll
            for (int k = 0; k < 8; ++k) atomicAdd((int*)&lh[idx[k]], 1);
        }
        __syncthreads();
        if (tid < NE) { const int c = (tb * 256) / CH_TOK; atomicAdd(&CNT[(l * NCHUNK + c) * 80 + tid], (unsigned)lh[tid]); }
    }
    __syncthreads();
}

DI void compute_pstart(CArgs& a, LAS unsigned char* lds, const int l, const int csel) {
    LAS int* ps = (LAS int*)(lds + LM_PSTART); LAS int* ts = (LAS int*)(lds + LM_TSTART);
    const unsigned* CNT = (const unsigned*)(a.ws + WS_CTL) + CW_CNT;
    const int ftid = fresh_tid(), wv = ftid >> 6, ln = ftid & 63;
    __syncthreads();
    if (wv < NCHUNK) {
        const int c = wv;
        const int cnt = (int)__hip_atomic_load(&CNT[(l * NCHUNK + c) * 80 + ln], __ATOMIC_RELAXED, __HIP_MEMORY_SCOPE_AGENT);
        const int pad = (cnt + 255) & ~255;
        int inc = pad;
#pragma unroll
        for (int off = 1; off < 64; off <<= 1) { const int t = shfl_up_i(inc, off, ln); if (ln >= off) inc += t; }
        const int exc = inc - pad;
        ps[c * 66 + ln] = exc; if (c == csel) ts[ln] = exc >> 8;
        if (ln == 63) { ps[c * 66 + 64] = inc; ps[c * 66 + 65] = inc + CH_TOK; if (c == csel) { ts[64] = inc >> 8; ts[65] = (inc + CH_TOK) >> 8; } }
    }
    __syncthreads();
}

DI void phase_place(CArgs& a, LAS unsigned char* lds, const int l, const bool dry) {
    compute_pstart(a, lds, l, 0);
    LAS int* ps = (LAS int*)(lds + LM_PSTART); LAS int* lh = (LAS int*)(lds + LM_LH); LAS int* lbase = (LAS int*)(lds + LM_LBASE);
    const int* EIDX = (const int*)(a.ws + WS_EIDX); int* TPOS = (int*)(a.ws + WS_TPOS); int* STOK = (int*)(a.ws + WS_STOK);
    unsigned* CNT = (unsigned*)(a.ws + WS_CTL) + CW_CNT; unsigned* CUR = (unsigned*)(a.ws + WS_CTL) + CW_CUR + (dry ? 2048 : 0);
    const int tid = fresh_tid();
    for (int tb = blockIdx.x; tb < NTOK / 256; tb += gridDim.x) {
        const int c = (tb * 256) / CH_TOK;
        __syncthreads();
        if (tid < 80) lh[tid] = 0;
        __syncthreads();
        int ee[8], rk[8];
        const size_t tok = (size_t)tb * 256 + (tid & 255);
        if (tid < 256) {
            const i32x4 e0 = *(const i32x4*)(EIDX + tok * 8), e1 = *(const i32x4*)(EIDX + tok * 8 + 4);
            ee[0] = e0[0]; ee[1] = e0[1]; ee[2] = e0[2]; ee[3] = e0[3]; ee[4] = e1[0]; ee[5] = e1[1]; ee[6] = e1[2]; ee[7] = e1[3];
#pragma unroll
            for (int k = 0; k < 8; ++k) rk[k] = atomicAdd((int*)&lh[ee[k]], 1);
        }
        __syncthreads();
        if (tid < NE) lbase[tid] = (int)atomicAdd(&CUR[(l * NCHUNK + c) * 80 + tid], (unsigned)lh[tid]);
        __syncthreads();
        if (tid < 256) {
            int pos[8];
#pragma unroll
            for (int k = 0; k < 8; ++k) { pos[k] = ps[c * 66 + ee[k]] + lbase[ee[k]] + rk[k]; STOK[(size_t)c * PMAX + pos[k]] = (int)tok; }
            *(i32x4*)(TPOS + tok * 8) = (i32x4){pos[0], pos[1], pos[2], pos[3]}; *(i32x4*)(TPOS + tok * 8 + 4) = (i32x4){pos[4], pos[5], pos[6], pos[7]};
        }
    }
    for (int pe = blockIdx.x; pe < 2 * NEX; pe += gridDim.x) {
        const int c = pe / NEX, e = pe % NEX; const int base = ps[c * 66 + e];
        if (e < NE) { const int cnt = (int)__hip_atomic_load(&CNT[(l * NCHUNK + c) * 80 + e], __ATOMIC_RELAXED, __HIP_MEMORY_SCOPE_AGENT); const int pad = (cnt + 255) & ~255;
            for (int i = cnt + tid; i < pad; i += 512) STOK[(size_t)c * PMAX + base + i] = c * CH_TOK; }
        else { for (int i = tid; i < CH_TOK; i += 512) STOK[(size_t)c * PMAX + base + i] = c * CH_TOK + i; }
    }
    __syncthreads();
}

DI void phase_comb(CArgs& a, LAS unsigned char* lds, const int l, const int c, const bool have_pstart, unsigned* queue) {
    if (!have_pstart) compute_pstart(a, lds, l, c);
    LAS int* ps = (LAS int*)(lds + LM_PSTART);
    LAS float* wff = (LAS float*)(lds + RING_OFF + 32768);
    const int tid = fresh_tid(), wid = tid >> 6, lane = tid & 63;
    if (l + 1 < DEPTH) { load_wff(a.w_in + (size_t)(l + 1) * D * INCOLS, wff); __syncthreads(); }
    const float* mod = (const float*)(a.ws + WS_MOD);
    const int* TPOS = (const int*)(a.ws + WS_TPOS); const float* GW = (const float*)(a.ws + WS_GW);
    const unsigned char* SLOT8 = (const unsigned char*)(a.ws + WS_R + R_SLOT) + (size_t)c * PMAX * 1024;
    bf16_t* U = (bf16_t*)(a.ws + WS_U); float* LF = (float*)(a.ws + WS_LOGF); bf16_t* XB = (bf16_t*)(a.ws + WS_XB);
    float g[16], bb[16];
    row_load_f32(a.ln_g + (size_t)(l * 2 + 1) * D, lane, g); row_load_f32(a.ln_b + (size_t)(l * 2 + 1) * D, lane, bb);
    const int shbase = ps[c * 66 + NE];
    typedef float f32x2 __attribute__((ext_vector_type(2)));
    const int rstride = gridDim.x * 8;
#define COMB_GRAB() ({ int v_ = 0; if (lane == 0) v_ = (int)xb_add(queue, 1u); __builtin_amdgcn_readfirstlane(v_); })
    int it = queue ? COMB_GRAB() : (int)(blockIdx.x * 8 + wid);
    const int itend = queue ? CH_TOK / 2 : CH_TOK, rs2 = queue ? CH_TOK / 2 : rstride;
    while (it < itend) {
        const int tr0 = it;
        it = queue ? COMB_GRAB() : it + 2 * rstride;
        int trr[2], tok[2]; bool okr[2];
#pragma unroll
        for (int q = 0; q < 2; ++q) { const int t = tr0 + q * rs2; okr[q] = t < CH_TOK; trr[q] = okr[q] ? t : tr0; tok[q] = c * CH_TOK + trr[q]; }
        i32x4 pp[2][2]; f32x4 ww[2][2];
#pragma unroll
        for (int q = 0; q < 2; ++q) { pp[q][0] = *(const i32x4*)(TPOS + (size_t)tok[q] * 8); pp[q][1] = *(const i32x4*)(TPOS + (size_t)tok[q] * 8 + 4);
            ww[q][0] = *(const f32x4*)(GW + (size_t)tok[q] * 8); ww[q][1] = *(const f32x4*)(GW + (size_t)tok[q] * 8 + 4); }
        u32x4 sw[2][9]; u32x4 xw[2][2]; float g2[2][16];
#pragma unroll
        for (int q = 0; q < 2; ++q) {
#pragma unroll
            for (int k = 0; k < 9; ++k) { const int pos = (k < 4) ? pp[q][0][k & 3] : ((k < 8) ? pp[q][1][k & 3] : shbase + trr[q]);
                sw[q][k] = __builtin_nontemporal_load((const u32x4*)(SLOT8 + (size_t)pos * 1024 + lane * 16)); }
#pragma unroll
            for (int j = 0; j < 2; ++j) xw[q][j] = __builtin_nontemporal_load((const u32x4*)(XB + (size_t)tok[q] * D + rc(lane) + 128 * j));
            row_load_f32(mod + (size_t)(l * 32 + (tok[q] >> 11)) * 6144 + 5120, lane, g2[q]);
        }
#pragma unroll
        for (int q = 0; q < 2; ++q) {
            float y[16];
#pragma unroll
            for (int i = 0; i < 16; ++i) y[i] = 0.f;
#pragma unroll
            for (int k = 0; k < 9; ++k) {
                const float wk = ((k < 4) ? ww[q][0][k & 3] : ((k < 8) ? ww[q][1][k & 3] : 1.0f)) * SLOT_INV;
#pragma unroll
                for (int d = 0; d < 4; ++d) { const f32x2 lo = __builtin_amdgcn_cvt_pk_f32_fp8((int)sw[q][k][d], false), hi = __builtin_amdgcn_cvt_pk_f32_fp8((int)sw[q][k][d], true);
                    y[d * 4 + 0] += wk * lo.x; y[d * 4 + 1] += wk * lo.y; y[d * 4 + 2] += wk * hi.x; y[d * 4 + 3] += wk * hi.y; }
            }
            float xv[16];
#pragma unroll
            for (int j = 0; j < 2; ++j) { const u32x4 w = xw[q][j];
                xv[j * 8 + 0] = bf_lo(w.x); xv[j * 8 + 1] = bf_hi(w.x); xv[j * 8 + 2] = bf_lo(w.y); xv[j * 8 + 3] = bf_hi(w.y); xv[j * 8 + 4] = bf_lo(w.z); xv[j * 8 + 5] = bf_hi(w.z); xv[j * 8 + 6] = bf_lo(w.w); xv[j * 8 + 7] = bf_hi(w.w); }
#pragma unroll
            for (int i = 0; i < 16; ++i) xv[i] = DN_ALPHA * xv[i] + (1.0f + g2[q][i]) * y[i];
            row_layernorm(xv, g, bb);
            if (okr[q]) {
                if (l + 1 < DEPTH) {
                    row_store_bf16(XB + (size_t)tok[q] * D, lane, xv);
                    emit_u_logf(xv, mod + (size_t)((l + 1) * 32 + (tok[q] >> 11)) * 6144, wff, a.b_forget + (l + 1) * 8, U + (size_t)tok[q] * D, LF + (size_t)tok[q] * 8, lane);
                } else row_store_f32_nt(a.out + (size_t)tok[q] * D, lane, xv);
            }
        }
    }
    __syncthreads();
}

DI void phase_attn(CArgs& a, LAS unsigned char* lds, const int var) {
    LAS unsigned char* ring = lds + RING_OFF;
    LAS float* bias2 = (LAS float*)(ring + att::BIAS_OFF);
    LAS float* wtot = (LAS float*)(lds + LM_LH);
    const bf16_t* proj = (const bf16_t*)(a.ws + WS_R + R_PROJ); bf16_t* Y = (bf16_t*)(a.ws + WS_R + R_Y);
    bf16_t* PART = (bf16_t*)(a.ws + WS_U); float* LSE = (float*)(a.ws + WS_LSE); const float* LF = (const float*)(a.ws + WS_LOGF);
    const int tid = fresh_tid(), wid = tid >> 6, lane = tid & 63;
    const int grp = __builtin_amdgcn_readfirstlane(tid >> 8);
    for (int bh = blockIdx.x; bh < NB * 8; bh += gridDim.x) {
        const int b = bh >> 3, h = bh & 7;
        const bf16_t* hm = proj + (size_t)(15 * b + 2 * h) * SEQ * 32;
        __syncthreads();
        {
            float v[4]; float run = 0.f;
#pragma unroll
            for (int i = 0; i < 4; ++i) { run += LF[(size_t)(b * SEQ + 4 * tid + i) * 8 + h]; v[i] = run; }
            float sc = run;
#pragma unroll
            for (int off = 1; off < 64; off <<= 1) { const float t = shfl_up_f(sc, off, lane); if (lane >= off) sc += t; }
            if (lane == 63) wtot[wid] = sc;
            __syncthreads();
            float base = sc - run;
            for (int w = 0; w < wid; ++w) base += wtot[w];
#pragma unroll
            for (int i = 0; i < 4; ++i) bias2[4 * tid + i] = -(base + v[i]) * LOG2E;
        }
        __syncthreads();
        if (var != 2) {
#pragma unroll 1
            for (int qb = 0; qb < SEQ / 256; ++qb) att::fx::fox_unit<8>(b, qb, hm, hm + QKV_T, hm + 2 * QKV_T, Y + h * 64, ring, bias2);
        }
        if (var != 1) { att::GenDil2 g3{b, 16, 1};
          att::attn_pass<1, att::GenDil2, 8>(ring, g3, hm + 3 * QKV_T, hm + 4 * QKV_T, hm + 5 * QKV_T, Y, 512 + h * 64, PART + (size_t)NTOK * 512, LSE + (size_t)NTOK * 8, nullptr, nullptr, nullptr, nullptr, h, var); }
        if (var != 1) { att::GenDil2 g2{b, 4, 4};
          att::attn_pass<1, att::GenDil2, 8>(ring, g2, hm + 3 * QKV_T, hm + 4 * QKV_T, hm + 5 * QKV_T, Y, 512 + h * 64, PART, LSE, nullptr, nullptr, nullptr, nullptr, h, var); }
        asm volatile("s_waitcnt vmcnt(0)" ::: "memory");
        __syncthreads();
        __builtin_amdgcn_fence(__ATOMIC_ACQUIRE, "agent");
        asm volatile("s_waitcnt vmcnt(0)" ::: "memory");
        if (var != 1) { att::GenDil2 g1{b, 1, 16};
          att::attn_pass<2, att::GenDil2, 8>(ring, g1, hm + 3 * QKV_T, hm + 4 * QKV_T, hm + 5 * QKV_T, Y, 512 + h * 64, nullptr, nullptr, PART, PART + (size_t)NTOK * 512, LSE, LSE + (size_t)NTOK * 8, h, var); }
    }
    __syncthreads();
}

DI void phase_comb(CArgs& a, LAS unsigned char* lds, const int l, const int c, const bool have_pstart, unsigned* queue);
DI void phase_gudn(CArgs& a, LAS unsigned char* lds, const int l, const int c, const int var, const int comb_c) {
    compute_pstart(a, lds, l, c);
    const LAS int* ts = (const LAS int*)(lds + LM_TSTART);
    LAS unsigned char* ring = lds + RING_OFF;
    const int ntiles = ts[NEX];
    const int cid = blockIdx.x, G = gridDim.x;
    const bool xmap = (G == 256);
    const int xx = cid & 7, sl = cid >> 3;
    const int lag = 0;
    if (comb_c >= 0 && lag) phase_comb(a, lds, l, comb_c, true, nullptr);
    int j0 = -1, e0 = 0, j1 = -1, e1 = 0;
#pragma unroll 1
    for (int r = 0;; ++r) {
        int j;
        if (xmap) { const int m = sl + 32 * r; j = 8 * (xx + 8 * (m >> 3)) + (m & 7); } else j = cid + r * G;
        const bool do_gu = j < ntiles;
        int e = 0;
        if (do_gu) { for (int k = 1; k < NEX; ++k) e += (ts[k] <= j) ? 1 : 0; } else j = -1;
        const int dj = lag ? j0 : j, de = lag ? e0 : e;
        if (j < 0 && dj < 0) break;
        if (j >= 0 && var != 2) {
            pg8::Gemm g{(const bf16_t*)(a.ws + WS_U), (const bf16_t*)(a.ws + WS_W + W_GU), D, D, D};
            pg8::TileOrder<true> S; S.pm = j; S.e = e; S.nN = 2; S.stok = (const int*)(a.ws + WS_STOK) + (size_t)c * PMAX; S.estride = (size_t)512 * D * 2;
            pg8::EpiGU E{(bf16_t*)(a.ws + WS_R + R_H)};
            pg8::gemm_phase<pg8::EpiGU, pg8::TileOrder<true>, true>(ring, g, S, E);
        }
        if (dj >= 0 && var != 1) {
            pg8::Gemm g{(const bf16_t*)(a.ws + WS_R + R_H), (const bf16_t*)(a.ws + WS_W + W_DN), 256, 256, 256};
            pg8::TileOrder<false> S; S.pm = dj; S.e = de; S.nN = 4; S.stok = nullptr; S.estride = (size_t)D * 256 * 2;
            pg8::EpiSlotF8 E{(var == 3) ? nullptr : (unsigned char*)(a.ws + WS_R + R_SLOT) + (size_t)c * PMAX * 1024};
            pg8::gemm_phase<pg8::EpiSlotF8, pg8::TileOrder<false>, true>(ring, g, S, E);
        }
        j0 = j; e0 = e;
    }
    if (comb_c >= 0 && !lag) phase_comb(a, lds, l, comb_c, true, nullptr);
    __syncthreads();
}

DI void phase_gudn_all(CArgs& a, LAS unsigned char* lds, const int l) {
    compute_pstart(a, lds, l, 0);
    const LAS int* ps = (const LAS int*)(lds + LM_PSTART);
    LAS unsigned char* ring = lds + RING_OFF;
    const int nt0 = ps[0 * 66 + 65] >> 8, nt1 = ps[1 * 66 + 65] >> 8, T = nt0 + nt1;
    const int cid = blockIdx.x, G = gridDim.x;
    const bool xmap = (G == 256);
    const int xx = cid & 7, sl = cid >> 3;
    unsigned* DONE = (unsigned*)(a.ws + WS_CTL) + CW_DONE + l;
    bool released = false;
#define GUDN_RELEASE() do { asm volatile("s_waitcnt vmcnt(0)" ::: "memory"); __syncthreads(); \
        if (fresh_tid() == 0) { __builtin_amdgcn_fence(__ATOMIC_RELEASE, "agent"); asm volatile("s_waitcnt vmcnt(0)" ::: "memory"); (void)xb_add(DONE, 1u); } released = true; } while (0)
#pragma unroll 1
    for (int r = 0;; ++r) {
        int j;
        if (xmap) { const int m = sl + 32 * r; j = 8 * (xx + 8 * (m >> 3)) + (m & 7); } else j = cid + r * G;
        if (j >= T) break;
        const int c = (j >= nt0) ? 1 : 0; const int jj = j - (c ? nt0 : 0);
        if (c == 1 && !released) GUDN_RELEASE();
        int e = 0;
        for (int k = 1; k < NEX; ++k) e += ((ps[c * 66 + k] >> 8) <= jj) ? 1 : 0;
        bf16_t* Hrel = (bf16_t*)(a.ws + WS_R + R_H) + ((ptrdiff_t)cid - (ptrdiff_t)jj) * 65536;
        {
            pg8::Gemm g{(const bf16_t*)(a.ws + WS_U), (const bf16_t*)(a.ws + WS_W + W_GU), D, D, D};
            pg8::TileOrder<true> S; S.pm = jj; S.e = e; S.nN = 2; S.stok = (const int*)(a.ws + WS_STOK) + (size_t)c * PMAX; S.estride = (size_t)512 * D * 2;
            pg8::EpiGU E{Hrel};
            pg8::gemm_phase<pg8::EpiGU, pg8::TileOrder<true>, true>(ring, g, S, E);
        }
        {
            pg8::Gemm g{(const bf16_t*)Hrel, (const bf16_t*)(a.ws + WS_W + W_DN), 256, 256, 256};
            pg8::TileOrder<false> S; S.pm = jj; S.e = e; S.nN = 4; S.stok = nullptr; S.estride = (size_t)D * 256 * 2;
            pg8::EpiSlotF8 E{(unsigned char*)(a.ws + WS_R + R_SLOT) + (size_t)c * PMAX * 1024};
            pg8::gemm_phase<pg8::EpiSlotF8, pg8::TileOrder<false>, true>(ring, g, S, E);
        }
    }
    if (!released) GUDN_RELEASE();
#undef GUDN_RELEASE
    if (fresh_tid() == 0) {
        unsigned sp = 0u;
        while (xb_ld(DONE) < (unsigned)G) { __builtin_amdgcn_s_sleep(2); if (++sp > (1u << 22)) break; }
        __builtin_amdgcn_fence(__ATOMIC_ACQUIRE, "agent");
        asm volatile("s_waitcnt vmcnt(0)" ::: "memory");
    }
    __syncthreads();
    phase_comb(a, lds, l, 0, true, (unsigned*)(a.ws + WS_CTL) + CW_CQ + l);
    __syncthreads();
}

constexpr int NPH = 13, NGP = 1 + DEPTH * NPH;
__global__ void __launch_bounds__(512, 2) fwd(Args a_byval) {
    extern __shared__ __attribute__((aligned(16))) unsigned char smem[];
    LAS unsigned char* lds = (LAS unsigned char*)smem;
    LAS unsigned char* ring = lds + RING_OFF;
    const int tid = fresh_tid();
    if (tid < 4) ((LAS unsigned*)(lds + LM_BAR))[tid] = 0u;
    __syncthreads();
    XcdBarrier bar; int g0, g1, do_sync;
    { CArgs& a = *KARGS(); unsigned* barw = (unsigned*)(a.ws + WS_CTL);
      bar.bar = barw; bar.x = 0; bar.st = (volatile LAS unsigned*)(lds + LM_BAR);
      if (a.sync) bar = xcd_barrier_post(barw, (volatile LAS unsigned*)(lds + LM_BAR));
      g0 = a.g0; g1 = a.g1; do_sync = a.sync; }
#ifndef PHMASK
#define PHMASK 0xFFFFFFFFu
#endif
#define PHON(k) ((PHMASK >> (k)) & 1u)
#ifndef PROBE_DUP
#define PROBE_DUP -1
#endif
#ifndef PROBE_DRY
#define PROBE_DRY -1
#endif
#ifndef ATT_VAR
#define ATT_VAR 0
#endif
#ifndef MOE_VAR
#define MOE_VAR 0
#endif
#define REP(k) for (int rep_ = ((PROBE_DUP) == (k) || (PROBE_DRY) == (k)) ? 0 : 1; rep_ < 2; ++rep_)
#define IN(gp) (g0 <= (gp) && (gp) < g1)
#define SEAM(gp) do { if (do_sync && (gp) + 1 < g1) xcd_barrier(bar); } while (0)
    const int G = gridDim.x, cid = blockIdx.x;
#define Wl ((const bf16_t*)(a.ws + WS_W))
#define U ((bf16_t*)(a.ws + WS_U))
#define PROJ ((bf16_t*)(a.ws + WS_R + R_PROJ))
#define Y ((bf16_t*)(a.ws + WS_R + R_Y))
#define HB ((bf16_t*)(a.ws + WS_R + R_H))
#define SLOT ((bf16_t*)(a.ws + WS_R + R_SLOT))
#define mod ((const float*)(a.ws + WS_MOD))
#define cosT ((const float*)(a.ws + WS_ROPE))
#define sinT ((const float*)(a.ws + WS_ROPE) + 2048 * 32)

    REP(16) if (PHON(16) && IN(0)) { CArgs& a = *KARGS(); phase_pre(a, ring); SEAM(0); }
    for (int l = 0; l < DEPTH; ++l) {
        const int gb = 1 + l * NPH;
        REP(0) if (PHON(0) && IN(gb + 0)) { CArgs& a = *KARGS(); phase_w(a, ring, l); SEAM(gb + 0); }
        REP(1) if (PHON(1) && IN(gb + 1)) { CArgs& a = *KARGS();
            pg8::Gemm g{U, (const bf16_t*)((const unsigned char*)Wl + W_IN), D, D, D}; pg8::StaticOrder S; S.init(NTOK, NPROJ, G, cid);
            pg8::EpiInProj E{PROJ, a.b_gate + l * 2048, cosT, sinT};
            pg8::gemm_phase<pg8::EpiInProj, pg8::StaticOrder, true>(ring, g, S, E);
            SEAM(gb + 1);
        }
        REP(2) if (PHON(2) && IN(gb + 2)) { CArgs& a = *KARGS(); phase_attn(a, lds, ((PROBE_DUP == 2) && rep_ == 0) ? ATT_VAR : 0); SEAM(gb + 2); }
        REP(3) if (PHON(3) && IN(gb + 3)) { CArgs& a = *KARGS();
            pg8::Gemm g{Y, (const bf16_t*)((const unsigned char*)Wl + W_BF), D, D, D}; pg8::StaticOrder S; S.init(NTOK, D, G, cid);
            pg8::EpiBranchFused E{U, PROJ};
            pg8::gemm_phase<pg8::EpiBranchFused, pg8::StaticOrder, true>(ring, g, S, E);
            SEAM(gb + 3);
        }
        REP(5) if (PHON(5) && IN(gb + 5)) { CArgs& a = *KARGS();
            pg8::Gemm g{U, (const bf16_t*)((const unsigned char*)Wl + W_O), D, D, D}; pg8::StaticOrder S; S.init(NTOK, D, G, cid);
            pg8::EpiOut E{l == 0 ? a.x : nullptr, (bf16_t*)(a.ws + WS_XB), mod + (size_t)l * 32 * 6144 + 2048};
            pg8::gemm_phase<pg8::EpiOut, pg8::StaticOrder, true>(ring, g, S, E);
            SEAM(gb + 5);
        }
        REP(6) if (PHON(6) && IN(gb + 6)) { CArgs& a = *KARGS(); phase_ln1(a, l, (PROBE_DRY == 6) && rep_ == 0); SEAM(gb + 6); }
        REP(7) if (PHON(7) && IN(gb + 7)) { CArgs& a = *KARGS();
            pg8::Gemm g{U, (const bf16_t*)((const unsigned char*)Wl + W_R), D, D, D}; pg8::StaticOrder S; S.init(NTOK, 256, G, cid);
            pg8::EpiRouter E{(float*)(a.ws + WS_LOGITS)};
            pg8::gemm_phase<pg8::EpiRouter, pg8::StaticOrder, true>(ring, g, S, E);
            SEAM(gb + 7);
        }
        REP(8) if (PHON(8) && IN(gb + 8)) { CArgs& a = *KARGS(); phase_route(a, lds, l, (PROBE_DRY == 8) && rep_ == 0); SEAM(gb + 8); }
        REP(9) if (PHON(9) && IN(gb + 9)) { CArgs& a = *KARGS(); phase_place(a, lds, l, (PROBE_DRY == 9) && rep_ == 0); SEAM(gb + 9); }
        static_assert(NCHUNK == 2, "phase program below is written for two chunks");
#if MK_ONE_LAUNCH
        if (PHON(10) && IN(gb + 10)) { CArgs& a = *KARGS(); phase_gudn_all(a, lds, l); SEAM(gb + 10); }
#else
        if (PHON(10) && IN(gb + 10)) { CArgs& a = *KARGS(); phase_gudn(a, lds, l, 0, 0, -1); SEAM(gb + 10); }
        if (PHON(11) && IN(gb + 11)) { CArgs& a = *KARGS(); phase_gudn(a, lds, l, 1, 0, 0); SEAM(gb + 11); }
#endif
        REP(12) if (PHON(12) && IN(gb + 12)) { CArgs& a = *KARGS(); phase_comb(a, lds, l, 1, false, nullptr); SEAM(gb + 12); }
    }
}

extern "C" void kernel_launch(void* const* d_in, const int* in_sizes, int n_in, void* d_out, int out_size, void* d_ws, size_t ws_size, hipStream_t stream) {
    static int grid = 0;
    if (grid == 0) {
        if (n_in != 20 || ws_size < WS_END2 + ((PROBE_DRY >= 0) ? DRY_BYTES : 0)) { fprintf(stderr, "kernel_launch: need 20 inputs and %zu bytes of workspace (got %d, %zu)\n", (size_t)WS_END2, n_in, ws_size); grid = -1; return; }
        int dev = 0, cus = 0;
        if (hipGetDevice(&dev) != hipSuccess || hipDeviceGetAttribute(&cus, hipDeviceAttributeMultiprocessorCount, dev) != hipSuccess) { grid = -1; return; }
        if (hipFuncSetAttribute((const void*)fwd, hipFuncAttributeMaxDynamicSharedMemorySize, LDS_BYTES) != hipSuccess) { fprintf(stderr, "kernel_launch: hipFuncSetAttribute failed\n"); grid = -1; return; }
        int per_cu = 0;
        if (hipOccupancyMaxActiveBlocksPerMultiprocessor(&per_cu, fwd, 512, LDS_BYTES) != hipSuccess || per_cu < 1) { fprintf(stderr, "kernel_launch: occupancy query says %d\n", per_cu); grid = -1; return; }
        grid = cus;
    }
    if (grid <= 0) return;
    hipMemsetAsync((char*)d_ws + WS_CTL, 0, CTL_BYTES, stream);
    Args a{};
    const float** f = (const float**)&a;
    for (int i = 0; i < 20; ++i) f[i] = (const float*)d_in[i];
    a.out = (float*)d_out; a.ws = (unsigned char*)d_ws; a.pad = 0;
#if MK_ONE_LAUNCH
    a.g0 = 0; a.g1 = NGP; a.sync = 1;
    fwd<<<dim3(grid), dim3(512), LDS_BYTES, stream>>>(a);
#else
    for (int gp = 0; gp < NGP; ++gp) { a.g0 = gp; a.g1 = gp + 1; a.sync = 0; fwd<<<dim3(grid), dim3(512), LDS_BYTES, stream>>>(a); }
#endif
}
```

```cpp
#include <hip/hip_runtime.h>
#include <cstdio>
#include <cstdint>

#define LAS __attribute__((address_space(3)))
typedef unsigned short bf16_t;
typedef short bf16x8 __attribute__((ext_vector_type(8)));
typedef short s16x4 __attribute__((ext_vector_type(4)));
typedef float f32x4 __attribute__((ext_vector_type(4)));
typedef float f32x16 __attribute__((ext_vector_type(16)));
typedef unsigned u32x4 __attribute__((ext_vector_type(4)));
typedef unsigned u32x2 __attribute__((ext_vector_type(2)));
typedef int i32x4 __attribute__((ext_vector_type(4)));
#define DI __device__ __forceinline__

constexpr int D = 1024, NB = 32, SEQ = 2048, NTOK = NB * SEQ, DEPTH = 4;
constexpr int NPROJ = 5120;
constexpr int INCOLS = 5128;
constexpr int NE = 64, NEX = 65, TOPK = 8;
constexpr int NCHUNK = 2, CH_TOK = NTOK / NCHUNK;
constexpr int PMAX_TILES = 1216, PMAX = PMAX_TILES * 256;
constexpr float QSCALE = 0.125f * 1.4426950408889634f;
constexpr float LOG2E = 1.4426950408889634f;
constexpr float DN_ALPHA = 1.6817928305074290f;
constexpr float LN_EPS = 1e-5f;
constexpr float NEGBIG = -1e30f;
constexpr float SLOT_SCALE = 16.0f, SLOT_INV = 1.0f / 16.0f;

constexpr size_t WS_CTL = 0;
constexpr size_t CTL_BYTES = 65536;
#ifndef MK_ONE_LAUNCH
#define MK_ONE_LAUNCH 1
#endif
constexpr int CW_CQ = 9280;
constexpr int CW_DONE = 9216;
constexpr int CW_CNT = 4096, CW_CUR = 4096 + 1024;
constexpr size_t WS_MOD = WS_CTL + CTL_BYTES;
constexpr size_t WS_ROPE = WS_MOD + (size_t)DEPTH * NB * 6144 * 4;
constexpr size_t WS_LOGF = WS_ROPE + 2 * 2048 * 32 * 4;
constexpr size_t WS_LOGITS = WS_LOGF + (size_t)NTOK * 8 * 4;
constexpr size_t WS_EIDX = WS_LOGITS + (size_t)NTOK * 64 * 4;
constexpr size_t WS_GW = WS_EIDX + (size_t)NTOK * 8 * 4;
constexpr size_t WS_TPOS = WS_GW + (size_t)NTOK * 8 * 4;
constexpr size_t WS_STOK = WS_TPOS + (size_t)NTOK * 8 * 4;
constexpr size_t WS_LSE = WS_STOK + (size_t)NCHUNK * PMAX * 4;
constexpr size_t WS_W = WS_LSE + (size_t)2 * NTOK * 8 * 4;
constexpr size_t W_IN = 0;
constexpr size_t W_BF = W_IN + (size_t)NPROJ * D * 2;
constexpr size_t W_BD = W_BF + (size_t)D * 512 * 2;
constexpr size_t W_O = W_BD + (size_t)D * 512 * 2;
constexpr size_t W_R = W_O + (size_t)D * D * 2;
constexpr size_t W_GU = W_R + (size_t)256 * D * 2;
constexpr size_t W_DN = W_GU + (size_t)NEX * 512 * D * 2;
constexpr size_t W_END = W_DN + (size_t)NEX * D * 256 * 2;
constexpr size_t WS_U = WS_W + W_END;
constexpr size_t WS_R = WS_U + (size_t)NTOK * D * 2;
constexpr size_t R_PROJ = 0;
constexpr size_t QKV_T = (size_t)NTOK * 512;
constexpr size_t GATE_OFF = 6 * QKV_T;
constexpr size_t R_Y = (size_t)NTOK * NPROJ * 2;
constexpr size_t R_ATT_END = R_Y + (size_t)NTOK * D * 2;
constexpr size_t R_H = 0;
constexpr size_t R_SLOT = (size_t)PMAX * 256 * 2;
constexpr size_t R_MOE_END = R_SLOT + (size_t)PMAX * 1024 * 2;
constexpr size_t WS_END = WS_R + (R_ATT_END > R_MOE_END ? R_ATT_END : R_MOE_END);
constexpr size_t WS_XB = WS_END;
constexpr size_t WS_END2 = WS_XB + (size_t)NTOK * D * 2;
constexpr size_t WS_DRY = WS_END2; constexpr size_t DRY_ROWS = 16384, DRY_BYTES = DRY_ROWS * D * 6 + DRY_ROWS * 32;

constexpr int LDS_MISC = 4096, RING_OFF = LDS_MISC, RING_BYTES = 143360, LDS_BYTES = RING_OFF + RING_BYTES;
constexpr int LM_BAR = 0, LM_TSTART = 64  , LM_PSTART = 512  , LM_LH = 1280  , LM_LBASE = 1664  , LM_RB = 2048  ;

DI int fresh_tid() { int t = threadIdx.x; asm volatile("" : "+v"(t)); return t; }
DI unsigned cvt_pk_bf16(float lo, float hi) { unsigned r; asm volatile("v_cvt_pk_bf16_f32 %0, %1, %2" : "=v"(r) : "v"(lo), "v"(hi)); return r; }
DI float bf_lo(unsigned w) { return __uint_as_float(w << 16); }
DI float bf_hi(unsigned w) { return __uint_as_float(w & 0xffff0000u); }
DI float wave_sum(float x) { x += __shfl_xor(x, 32); x += __shfl_xor(x, 16); x += __shfl_xor(x, 8); x += __shfl_xor(x, 4); x += __shfl_xor(x, 2); x += __shfl_xor(x, 1); return x; }
DI int shfl_up_i(int v, int off, int ln) { return __builtin_amdgcn_ds_bpermute((ln - off) * 4, v); }
DI float shfl_up_f(float v, int off, int ln) { return __int_as_float(__builtin_amdgcn_ds_bpermute((ln - off) * 4, __float_as_int(v))); }
DI float ub0(unsigned w) { float r; asm("v_cvt_f32_ubyte0 %0, %1" : "=v"(r) : "v"(w)); return r; }
DI float ub1(unsigned w) { float r; asm("v_cvt_f32_ubyte1 %0, %1" : "=v"(r) : "v"(w)); return r; }
DI float ub2(unsigned w) { float r; asm("v_cvt_f32_ubyte2 %0, %1" : "=v"(r) : "v"(w)); return r; }
DI float ub3(unsigned w) { float r; asm("v_cvt_f32_ubyte3 %0, %1" : "=v"(r) : "v"(w)); return r; }
DI float fast_sigmoid(float x) { return __builtin_amdgcn_rcpf(1.0f + __builtin_amdgcn_exp2f(-x * LOG2E)); }

#define XB_TMO      128
#define XB_XCNT(j)  (256  + 64 * (j))
#define XB_XSUB(j)  (1280 + 64 * (j))
#define XB_XGEN(j)  (2304 + 64 * (j))
#define XB_TOP      3328
#define XB_TOPGEN   3392
#define XCD_BAR_WORDS 3456
#define XB_SPIN_CAP (1u << 18)
__device__ __forceinline__ unsigned xb_ld(unsigned* p)              { return __hip_atomic_load(p, __ATOMIC_RELAXED, __HIP_MEMORY_SCOPE_AGENT); }
__device__ __forceinline__ unsigned xb_add(unsigned* p, unsigned v) { return __hip_atomic_fetch_add(p, v, __ATOMIC_RELAXED, __HIP_MEMORY_SCOPE_AGENT); }
__device__ __forceinline__ unsigned xb_xcc_id() { return (unsigned)__builtin_amdgcn_s_getreg((3 << 11) | 20) & 0xFu; }
#define XB_SPIN(cond, bar) do { unsigned _sp = 0; while (cond) { __builtin_amdgcn_s_sleep(1); \
    if ((++_sp & 255u) == 0u) { if (xb_ld(&(bar)[XB_TMO])) break; if (_sp > XB_SPIN_CAP) { atomicAdd(&(bar)[XB_TMO], 1u); break; } } } } while (0)
struct XcdBarrier { unsigned* bar; unsigned x; volatile LAS unsigned* st; };
__device__ __forceinline__ XcdBarrier xcd_barrier_post(unsigned* bar, volatile LAS unsigned* st) {
    XcdBarrier b; b.bar = bar; b.x = xb_xcc_id(); b.st = st;
    if (threadIdx.x == 0) (void)xb_add(&bar[XB_XCNT(b.x)], 1u);
    return b;
}
__device__ __forceinline__ void xcd_barrier_complete(unsigned* bar, unsigned x, unsigned& nloc, unsigned& nx) {
    const unsigned G = gridDim.x * gridDim.y * gridDim.z;
    unsigned sum, cnt, mine, sp = 0u;
    for (;;) {
        sum = 0u; cnt = 0u; mine = 0u;
#pragma unroll
        for (unsigned j = 0; j < 16; ++j) { const unsigned c = xb_ld(&bar[XB_XCNT(j)]); sum += c; cnt += (c > 0u) ? 1u : 0u; mine = (j == x) ? c : mine; }
        if (sum == G) break;
        __builtin_amdgcn_s_sleep(1);
        if ((++sp & 255u) == 0u) { if (xb_ld(&bar[XB_TMO])) break; if (sp > XB_SPIN_CAP) { atomicAdd(&bar[XB_TMO], 1u); break; } }
    }
    nloc = mine > 0u ? mine : 1u; nx = cnt > 0u ? cnt : 1u;
}
__device__ __forceinline__ void xcd_barrier(const XcdBarrier& b) {
    asm volatile("s_waitcnt vmcnt(0)" ::: "memory");
    __syncthreads();
    if (threadIdx.x == 0) {
        unsigned* bar = b.bar;
        __builtin_amdgcn_s_waitcnt(0);
        unsigned nloc = b.st[0], nx = b.st[1];
        if (nloc == 0u) { xcd_barrier_complete(bar, b.x, nloc, nx); b.st[0] = nloc; b.st[1] = nx; }
        const unsigned old = xb_add(&bar[XB_XSUB(b.x)], 1u);
        const unsigned gen = old / nloc;
        if (old + 1u == (gen + 1u) * nloc) {
            __builtin_amdgcn_fence(__ATOMIC_RELEASE, "agent");
            asm volatile("s_waitcnt vmcnt(0)" ::: "memory");
            const unsigned og = xb_add(&bar[XB_TOP], 1u);
            const unsigned tg = og / nx;
            if (og + 1u == (tg + 1u) * nx) xb_add(&bar[XB_TOPGEN], 1u);
            else XB_SPIN(xb_ld(&bar[XB_TOPGEN]) == tg, bar);
            __builtin_amdgcn_fence(__ATOMIC_ACQUIRE, "agent");
            xb_add(&bar[XB_XGEN(b.x)], 1u);
            asm volatile("s_waitcnt vmcnt(0)" ::: "memory");
        } else {
            XB_SPIN(xb_ld(&bar[XB_XGEN(b.x)]) == gen, bar);
            __builtin_amdgcn_fence(__ATOMIC_ACQUIRE, "agent");
            asm volatile("s_waitcnt vmcnt(0)" ::: "memory");
        }
    }
    __syncthreads();
}

namespace pg8 {
constexpr int BM = 256, BK = 64, HALF = 128, HTB = HALF * BK * 2, STAGE_BYTES = 8 * HTB, NXCD = 8, WGM = 8;
__host__ __device__ __forceinline__ int lds_byte(int r, int c) { const int st = (r >> 4) * 2 + (c >> 5), rr = r & 15, cc = c & 31, ob = rr * 64 + cc * 2; return st * 1024 + (ob ^ (((ob >> 9) & 1) << 5)); }
__host__ __device__ __forceinline__ void stage_rc(int b, int& R, int& C) { const int st = b / 1024, sb = b % 1024, swz = sb ^ (((sb >> 9) & 1) << 5); R = (st >> 1) * 16 + swz / 64; C = (st & 1) * 32 + (swz % 64) / 2; }
__host__ __device__ __forceinline__ int perm32(int rho) { const int n = rho >> 4, i = rho & 15; return 8 * (i >> 2) + 4 * n + (i & 3); }

struct Unit { int pm, pn, e; };
struct Gemm { const bf16_t* A; const bf16_t* Bt; int lda, ldb, K; };

struct StaticOrder {
    static constexpr bool GATHER = false, SAMEPANEL = false;
    int nM, nN, nwg, G, c;
    DI void init(int M, int N, int G_, int c_) { nM = M / BM; nN = N / BM; nwg = nM * nN; G = G_; c = c_; }
    DI bool next(int i, Unit& u) const {
        const long L = (long)i * G + c; if (L >= nwg) return false;
        int wgid = (int)L; { const int q = nwg / NXCD, r = nwg % NXCD, xcd = wgid % NXCD, off = wgid / NXCD; wgid = (xcd < r ? xcd * (q + 1) : r * (q + 1) + (xcd - r) * q) + off; }
        const int nig = WGM * nN, gid = wgid / nig, fm = gid * WGM, gsz = (nM - fm) < WGM ? (nM - fm) : WGM;
        u.pm = fm + ((wgid % nig) % gsz); u.pn = (wgid % nig) / gsz; u.e = 0; return true;
    }
    DI const char* abase(const Gemm& g, const Unit& u) const { return (const char*)g.A + (size_t)u.pm * (size_t)(BM * 2) * g.lda; }
    DI const char* bbase(const Gemm& g, const Unit& u) const { return (const char*)g.Bt + (size_t)u.pn * (size_t)(BM * 2) * g.ldb; }
    DI void goffs(const Gemm&, const Unit&, int, unsigned (&)[2][2]) const {}
};
template <bool GATH> struct MoeOrder {
    static constexpr bool GATHER = GATH, SAMEPANEL = false;
    int nN, ntiles, G, c; const LAS int* tstart; const int* stok; size_t estride  ;
    DI bool next(int i, Unit& u) const {
        const long L = (long)i * G + c; if (L >= (long)ntiles * nN) return false;
        u.pm = (int)(L / nN); u.pn = (int)(L % nN);
        int e = 0;
#pragma unroll 1
        for (int k = 1; k < NEX; ++k) e += (tstart[k] <= u.pm) ? 1 : 0;
        u.e = e; return true;
    }
    DI const char* abase(const Gemm& g, const Unit& u) const { return GATH ? (const char*)g.A : (const char*)g.A + (size_t)u.pm * (size_t)(BM * 2) * g.lda; }
    DI const char* bbase(const Gemm& g, const Unit& u) const { return (const char*)g.Bt + (size_t)u.e * estride + (size_t)u.pn * (size_t)(BM * 2) * g.ldb; }
    DI void goffs(const Gemm& g, const Unit& u, int tid, unsigned (&o)[2][2]) const {
        if constexpr (GATH) {
            int R0, C0; stage_rc(tid * 16, R0, C0);
            int t[2][2];
#pragma unroll
            for (int h = 0; h < 2; ++h)
#pragma unroll
                for (int i = 0; i < 2; ++i) t[h][i] = stok[u.pm * BM + h * HALF + R0 + 64 * i];
            asm volatile("s_waitcnt vmcnt(0)" ::: "memory");
#pragma unroll
            for (int h = 0; h < 2; ++h)
#pragma unroll
                for (int i = 0; i < 2; ++i) o[h][i] = (unsigned)(t[h][i] * g.lda + C0) * 2u;
        }
    }
};

template <bool GATH> struct TileOrder {
    static constexpr bool GATHER = GATH, SAMEPANEL = true;
    int pm, e, nN; const int* stok; size_t estride; int pt[2][2]; bool havept = false;
    DI bool next(int i, Unit& u) const { if (i >= nN) return false; u.pm = pm; u.pn = i; u.e = e; return true; }
    DI const char* abase(const Gemm& g, const Unit& u) const { return GATH ? (const char*)g.A : (const char*)g.A + (size_t)u.pm * (size_t)(BM * 2) * g.lda; }
    DI const char* bbase(const Gemm& g, const Unit& u) const { return (const char*)g.Bt + (size_t)u.e * estride + (size_t)u.pn * (size_t)(BM * 2) * g.ldb; }
    DI void goffs(const Gemm& g, const Unit& u, int tid, unsigned (&o)[2][2]) const {
        if constexpr (GATH) {
            int R0, C0; stage_rc(tid * 16, R0, C0);
            int t[2][2];
            if (havept) {
#pragma unroll
                for (int h = 0; h < 2; ++h)
#pragma unroll
                    for (int i = 0; i < 2; ++i) t[h][i] = pt[h][i];
            } else {
#pragma unroll
                for (int h = 0; h < 2; ++h)
#pragma unroll
                    for (int i = 0; i < 2; ++i) t[h][i] = stok[u.pm * BM + h * HALF + R0 + 64 * i];
                asm volatile("s_waitcnt vmcnt(0)" ::: "memory");
            }
#pragma unroll
            for (int h = 0; h < 2; ++h)
#pragma unroll
                for (int i = 0; i < 2; ++i) o[h][i] = (unsigned)(t[h][i] * g.lda + C0) * 2u;
        }
    }
};

typedef f32x4 Acc[2][2][4][2];

template <class Epi, class Sched, bool ALIGN_EPI>
__device__ __forceinline__ void gemm_phase(LAS unsigned char* lds, const Gemm g, const Sched& S, const Epi& E) {
    const int tid = fresh_tid(), wid = __builtin_amdgcn_readfirstlane(tid >> 6), lane = tid & 63, wr = wid >> 2, wc = wid & 3, fr = lane & 15, fq = lane >> 4;
    const int K = g.K, nt = K / BK;
    unsigned voffA[2], voffB[2];
#pragma unroll
    for (int i = 0; i < 2; ++i) { int R, C; stage_rc(tid * 16 + i * 8192, R, C); const int Rb = Epi::PERM ? ((R & ~31) + perm32(R & 31)) : R;
        voffA[i] = (unsigned)(R * g.lda + C) * 2u; voffB[i] = (unsigned)(Rb * g.ldb + C) * 2u; }
    const size_t kstep = (size_t)(BK * 2);
    const size_t hstepA = (size_t)HALF * g.lda * 2;
    const size_t hstepB = (size_t)HALF * g.ldb * 2;
    const unsigned ldsw = (unsigned)wid * 1024u;
    const int aoff = lds_byte(wr * 64 + fr, fq * 8), boff = lds_byte(wc * 32 + fr, fq * 8);
#define PG8_SA(b, h) (((b) * 2 + (h)) * HTB)
#define PG8_SB(b, h) ((4 + (b) * 2 + (h)) * HTB)
#define PG8_STAGE(bufoff, gbase, voff) do { _Pragma("unroll") for (int _i = 0; _i < 2; ++_i) \
        __builtin_amdgcn_global_load_lds((const unsigned*)((const char*)(gbase) + (voff)[_i]), (LAS unsigned*)(lds + (bufoff) + ldsw + _i * 8192), 16, 0, 0); } while (0)
#define PG8_STAGE_A(bufoff, gbase, h, og) do { if constexpr (Sched::GATHER) { PG8_STAGE(bufoff, gbase, (og)[h]); } else { PG8_STAGE(bufoff, (gbase) + (h) * hstepA, voffA); } } while (0)
#define PG8_LDA(dst, b, h) do { _Pragma("unroll") for (int m = 0; m < 4; ++m) _Pragma("unroll") for (int k = 0; k < 2; ++k) dst[m][k] = *(const LAS bf16x8*)(lds + PG8_SA(b, h) + aoff + m * 2048 + k * 1024); } while (0)
#define PG8_LDB(dst, b, h) do { _Pragma("unroll") for (int n = 0; n < 2; ++n) _Pragma("unroll") for (int k = 0; k < 2; ++k) dst[n][k] = *(const LAS bf16x8*)(lds + PG8_SB(b, h) + boff + n * 2048 + k * 1024); } while (0)
#define PG8_MMA(ai, bj, At, Bt) do { __builtin_amdgcn_s_setprio(1); _Pragma("unroll") for (int m = 0; m < 4; ++m) _Pragma("unroll") for (int n = 0; n < 2; ++n) _Pragma("unroll") for (int k = 0; k < 2; ++k) \
        acc[ai][bj][m][n] = __builtin_amdgcn_mfma_f32_16x16x32_bf16(Bt[n][k], At[m][k], acc[ai][bj][m][n], 0, 0, 0); __builtin_amdgcn_s_setprio(0); } while (0)
#define PG8_WAIT_V(n) asm volatile("s_waitcnt vmcnt(" #n ")" ::: "memory")
#define PG8_WAIT_L(n) asm volatile("s_waitcnt lgkmcnt(" #n ")" ::: "memory")
#define PG8_BAR __builtin_amdgcn_s_barrier()
#define PG8_SCHED __builtin_amdgcn_sched_barrier(0)
    Unit cur, nxt; int ui = 0;
    if (!S.next(0, cur)) return;
    Acc acc;
#pragma unroll
    for (int a = 0; a < 2; ++a)
#pragma unroll
        for (int b = 0; b < 2; ++b)
#pragma unroll
            for (int m = 0; m < 4; ++m)
#pragma unroll
                for (int n = 0; n < 2; ++n) acc[a][b][m][n] = (f32x4){0.f, 0.f, 0.f, 0.f};
    bf16x8 At[4][2], B0[2][2], B1[2][2];
    unsigned oA[2][2], noA[2][2];
    if constexpr (Sched::GATHER) { S.goffs(g, cur, tid, oA);
#pragma unroll
        for (int h = 0; h < 2; ++h)
#pragma unroll
            for (int i = 0; i < 2; ++i) noA[h][i] = oA[h][i]; }
    const char* cA = S.abase(g, cur); const char* cB = S.bbase(g, cur);
    PG8_STAGE(PG8_SB(0, 0), cB, voffB); PG8_STAGE(PG8_SB(0, 1), cB + hstepB, voffB); PG8_STAGE_A(PG8_SA(0, 0), cA, 0, oA); PG8_STAGE_A(PG8_SA(0, 1), cA, 1, oA);
    if (wr == 1) PG8_BAR;
    PG8_WAIT_V(2); PG8_BAR;
    PG8_STAGE(PG8_SB(1, 0), cB + kstep, voffB); PG8_STAGE_A(PG8_SA(1, 0), cA + kstep, 0, oA); PG8_STAGE(PG8_SB(1, 1), cB + hstepB + kstep, voffB);
    PG8_WAIT_V(6); PG8_BAR;
    for (;;) {
        const bool has_next = S.next(ui + 1, nxt);
        const char* nA = has_next ? S.abase(g, nxt) : cA; const char* nB = has_next ? S.bbase(g, nxt) : cB;
#pragma unroll 1
        for (int t = 0; t < nt; t += 2) {
            const bool last = (t == nt - 2);
            const char* a1 = cA + (size_t)(t + 1) * kstep;
            const char* a2 = last ? nA : cA + (size_t)(t + 2) * kstep; const char* b2 = last ? nB : cB + (size_t)(t + 2) * kstep;
            const char* a3 = a2 + kstep; const char* b3 = b2 + kstep;
            if constexpr (Epi::MIDHOOK) { if (t == (nt >> 1)) E.mid(acc, cur, wr, wc, fr, fq); }
            unsigned xo[2][2];
            if constexpr (Sched::GATHER) {
                if constexpr (Sched::SAMEPANEL) {
#pragma unroll
                    for (int h = 0; h < 2; ++h)
#pragma unroll
                        for (int i = 0; i < 2; ++i) xo[h][i] = oA[h][i];
                } else {
                    if (last && has_next && nxt.pm != cur.pm) S.goffs(g, nxt, tid, noA);
#pragma unroll
                    for (int h = 0; h < 2; ++h)
#pragma unroll
                        for (int i = 0; i < 2; ++i) xo[h][i] = last ? noA[h][i] : oA[h][i];
                }
            }
            PG8_LDB(B0, 0, 0); PG8_LDB(B1, 0, 1); PG8_SCHED; PG8_LDA(At, 0, 0); PG8_STAGE_A(PG8_SA(1, 1), a1, 1, oA);
            PG8_WAIT_V(8); PG8_WAIT_L(0); PG8_BAR; PG8_MMA(0, 0, At, B0); PG8_MMA(0, 1, At, B1); PG8_BAR; PG8_SCHED;
            PG8_LDA(At, 0, 1); PG8_STAGE(PG8_SB(0, 0), b2, voffB); PG8_STAGE(PG8_SB(0, 1), b2 + hstepB, voffB); PG8_STAGE_A(PG8_SA(0, 0), a2, 0, xo);
            PG8_WAIT_V(8); PG8_WAIT_L(0); PG8_BAR; PG8_MMA(1, 0, At, B0); PG8_MMA(1, 1, At, B1); PG8_BAR; PG8_SCHED;
            PG8_LDB(B0, 1, 0); PG8_LDB(B1, 1, 1); PG8_SCHED; PG8_LDA(At, 1, 0); PG8_STAGE_A(PG8_SA(0, 1), a2, 1, xo);
            PG8_WAIT_V(8); PG8_WAIT_L(0); PG8_BAR; PG8_MMA(0, 0, At, B0); PG8_MMA(0, 1, At, B1); PG8_BAR; PG8_SCHED;
            PG8_LDA(At, 1, 1); PG8_STAGE(PG8_SB(1, 0), b3, voffB); PG8_STAGE(PG8_SB(1, 1), b3 + hstepB, voffB); PG8_STAGE_A(PG8_SA(1, 0), a3, 0, xo);
            PG8_WAIT_V(8); PG8_WAIT_L(0); PG8_BAR; PG8_MMA(1, 0, At, B0); PG8_MMA(1, 1, At, B1); PG8_BAR; PG8_SCHED;
        }
        if constexpr (ALIGN_EPI) { if (wr == 0) PG8_BAR; }
        E(acc, cur, wr, wc, fr, fq);
        if (!has_next) break;
#pragma unroll
        for (int a = 0; a < 2; ++a)
#pragma unroll
            for (int b = 0; b < 2; ++b)
#pragma unroll
                for (int m = 0; m < 4; ++m)
#pragma unroll
                    for (int n = 0; n < 2; ++n) acc[a][b][m][n] = (f32x4){0.f, 0.f, 0.f, 0.f};
        cur = nxt; cA = nA; cB = nB; ++ui;
        if constexpr (Sched::GATHER) {
#pragma unroll
            for (int h = 0; h < 2; ++h)
#pragma unroll
                for (int i = 0; i < 2; ++i) oA[h][i] = noA[h][i]; }
        if constexpr (ALIGN_EPI) { if (wr == 1) PG8_BAR; }
    }
    PG8_WAIT_V(0);
    if constexpr (!ALIGN_EPI) { if (wr == 0) PG8_BAR; }
    PG8_BAR;
#undef PG8_SA
#undef PG8_SB
#undef PG8_STAGE
#undef PG8_STAGE_A
#undef PG8_LDA
#undef PG8_LDB
#undef PG8_MMA
#undef PG8_WAIT_V
#undef PG8_WAIT_L
#undef PG8_BAR
#undef PG8_SCHED
}

DI u32x4 pack8(const f32x4 v0, const f32x4 v1) { u32x4 w; w.x = cvt_pk_bf16(v0[0], v0[1]); w.y = cvt_pk_bf16(v0[2], v0[3]); w.z = cvt_pk_bf16(v1[0], v1[1]); w.w = cvt_pk_bf16(v1[2], v1[3]); return w; }
DI void unpack8(const u32x4 w, f32x4& v0, f32x4& v1) { v0 = (f32x4){bf_lo(w.x), bf_hi(w.x), bf_lo(w.y), bf_hi(w.y)}; v1 = (f32x4){bf_lo(w.z), bf_hi(w.z), bf_lo(w.w), bf_hi(w.w)}; }

struct EpiInProj {
    static constexpr bool PERM = true, MIDHOOK = false;
    bf16_t* P; const float* bgate; const float* cosT; const float* sinT;
    DI void operator()(const Acc& acc, const Unit& u, int wr, int wc, int fr, int fq) const {
        const int pn = u.pn;
        const int srow = (u.pm & 7) * BM + wr * 64 + fr;
        if (pn >= 12) {
            const int col0 = (pn - 12) * BM + wc * 32 + 8 * fq;
            f32x4 bv[2][2];
#pragma unroll
            for (int bj = 0; bj < 2; ++bj)
#pragma unroll
                for (int n = 0; n < 2; ++n) bv[bj][n] = *(const f32x4*)(bgate + col0 + bj * HALF + 4 * n);
            unsigned char* rowp = (unsigned char*)(P + GATE_OFF) + (size_t)(u.pm * BM + wr * 64 + fr) * 2048 + ((pn - 12) * 16 + wc * 4 + fq) * 16;
#pragma unroll
            for (int ai = 0; ai < 2; ++ai) {
#pragma unroll
                for (int m = 0; m < 4; ++m) { u32x4 w;
#pragma unroll
                    for (int bj = 0; bj < 2; ++bj)
#pragma unroll
                        for (int n = 0; n < 2; ++n) { const f32x4 v = acc[ai][bj][m][n] + bv[bj][n]; unsigned t = 0;
                            t = __builtin_amdgcn_cvt_pk_u8_f32(fmaxf(fast_sigmoid(v[0]) * 255.0f, 1.0f), 0, t); t = __builtin_amdgcn_cvt_pk_u8_f32(fmaxf(fast_sigmoid(v[1]) * 255.0f, 1.0f), 1, t);
                            t = __builtin_amdgcn_cvt_pk_u8_f32(fmaxf(fast_sigmoid(v[2]) * 255.0f, 1.0f), 2, t); t = __builtin_amdgcn_cvt_pk_u8_f32(fmaxf(fast_sigmoid(v[3]) * 255.0f, 1.0f), 3, t);
                            w[bj * 2 + n] = t; }
                    *(u32x4*)rowp = w;
                    rowp += (size_t)16 * 2048; asm volatile("" : "+v"(rowp)); }
                rowp += (size_t)(HALF - 64) * 2048; }
            return;
        }
        const int cin0 = (pn & 1) * BM + wc * 32 + 8 * fq;
        bf16_t* tp = P + (size_t)(pn >> 1) * QKV_T + ((size_t)(((u.pm >> 3) * 8 + (cin0 >> 6)) * 2 + ((cin0 >> 5) & 1)) * SEQ + srow) * 32 + (cin0 & 31);
        if (pn >= 6 && pn < 10) {
            const float sc = (pn < 8) ? QSCALE : 1.0f;
            const int g = 4 * (wc & 1) + fq;
            int pos = srow;
#pragma unroll
            for (int ai = 0; ai < 2; ++ai) {
#pragma unroll
                for (int m = 0; m < 4; ++m) {
                    const f32x4 cs = *(const f32x4*)(cosT + pos * 32 + 4 * g) * sc, sn = *(const f32x4*)(sinT + pos * 32 + 4 * g) * sc;
#pragma unroll
                    for (int bj = 0; bj < 2; ++bj) { const f32x4 x1 = acc[ai][bj][m][0], x2 = acc[ai][bj][m][1];
                        *(u32x4*)(tp + (size_t)bj * 2 * SEQ * 64) = pack8(x1 * cs - x2 * sn, x2 * cs + x1 * sn); }
                    tp += 16 * 32; pos += 16; asm volatile("" : "+v"(tp)); }
                tp += (HALF - 64) * 32; pos += HALF - 64; }
        } else {
            const float sc = (pn < 2) ? QSCALE : 1.0f;
#pragma unroll
            for (int ai = 0; ai < 2; ++ai) {
#pragma unroll
                for (int m = 0; m < 4; ++m) {
#pragma unroll
                    for (int bj = 0; bj < 2; ++bj) *(u32x4*)(tp + (size_t)bj * 2 * SEQ * 64) = pack8(acc[ai][bj][m][0] * sc, acc[ai][bj][m][1] * sc);
                    tp += 16 * 32; asm volatile("" : "+v"(tp)); }
                tp += (HALF - 64) * 32; }
        }
    }
};
struct EpiBranchFused {
    static constexpr bool PERM = true, MIDHOOK = true;
    bf16_t* T; const bf16_t* P;
    DI void mid(Acc& acc, const Unit& u, int wr, int wc, int fr, int fq) const {
        const int row0 = u.pm * BM + wr * 64 + fr;
        const unsigned char* gp = (const unsigned char*)(P + GATE_OFF) + (size_t)row0 * 2048 + (u.pn * 16 + wc * 4 + fq) * 16;
#pragma unroll
        for (int ai = 0; ai < 2; ++ai) {
#pragma unroll
            for (int m = 0; m < 4; ++m) {
                const u32x4 fw = *(const u32x4*)gp, dw = *(const u32x4*)(gp + 1024);
#pragma unroll
                for (int bj = 0; bj < 2; ++bj)
#pragma unroll
                    for (int n = 0; n < 2; ++n) { const unsigned f = fw[bj * 2 + n], d = dw[bj * 2 + n];
                        acc[ai][bj][m][n][0] *= ub0(f) * __builtin_amdgcn_rcpf(ub0(d)); acc[ai][bj][m][n][1] *= ub1(f) * __builtin_amdgcn_rcpf(ub1(d));
                        acc[ai][bj][m][n][2] *= ub2(f) * __builtin_amdgcn_rcpf(ub2(d)); acc[ai][bj][m][n][3] *= ub3(f) * __builtin_amdgcn_rcpf(ub3(d)); }
                gp += (size_t)16 * 2048; asm volatile("" : "+v"(gp)); }
            gp += (size_t)(HALF - 64) * 2048; }
    }
    DI void operator()(const Acc& acc, const Unit& u, int wr, int wc, int fr, int fq) const {
        const int row0 = u.pm * BM + wr * 64 + fr, col0 = u.pn * BM + wc * 32 + 8 * fq;
        const unsigned char* gp = (const unsigned char*)(P + GATE_OFF) + (size_t)row0 * 2048 + 1024 + (u.pn * 16 + wc * 4 + fq) * 16; bf16_t* tp = T + (size_t)row0 * D + col0;
        constexpr float I255 = 1.0f / 255.0f;
#pragma unroll
        for (int ai = 0; ai < 2; ++ai) {
#pragma unroll
            for (int m = 0; m < 4; ++m) {
                const u32x4 dw = *(const u32x4*)gp;
#pragma unroll
                for (int bj = 0; bj < 2; ++bj) { const unsigned d0 = dw[bj * 2], d1 = dw[bj * 2 + 1];
                    const f32x4 g0 = (f32x4){ub0(d0), ub1(d0), ub2(d0), ub3(d0)} * I255, g1 = (f32x4){ub0(d1), ub1(d1), ub2(d1), ub3(d1)} * I255;
                    *(u32x4*)(tp + bj * HALF) = pack8(acc[ai][bj][m][0] * g0, acc[ai][bj][m][1] * g1); }
                gp += (size_t)16 * 2048; tp += (size_t)16 * D; asm volatile("" : "+v"(gp), "+v"(tp)); }
            gp += (size_t)(HALF - 64) * 2048; tp += (size_t)(HALF - 64) * D; }
    }
};
struct EpiOut {
    static constexpr bool PERM = true, MIDHOOK = false;
    const float* xin32; bf16_t* xb; const float* gmod;
    DI void operator()(const Acc& acc, const Unit& u, int wr, int wc, int fr, int fq) const {
        const int row0 = u.pm * BM + wr * 64 + fr, col0 = u.pn * BM + wc * 32 + 8 * fq;
        const float* gm = gmod + (size_t)(u.pm >> 3) * 6144 + col0;
        f32x4 gv[2][2];
#pragma unroll
        for (int bj = 0; bj < 2; ++bj)
#pragma unroll
            for (int n = 0; n < 2; ++n) gv[bj][n] = *(const f32x4*)(gm + bj * HALF + n * 4) + 1.0f;
        size_t off = (size_t)row0 * D + col0;
#pragma unroll
        for (int ai = 0; ai < 2; ++ai) {
#pragma unroll
            for (int m = 0; m < 4; ++m) {
#pragma unroll
                for (int bj = 0; bj < 2; ++bj) { f32x4 x0, x1;
                    if (xin32) { x0 = *(const f32x4*)(xin32 + off + bj * HALF); x1 = *(const f32x4*)(xin32 + off + bj * HALF + 4); }
                    else { const u32x4 xw = *(const u32x4*)(xb + off + bj * HALF); unpack8(xw, x0, x1); }
                    *(u32x4*)(xb + off + bj * HALF) = pack8(x0 * DN_ALPHA + gv[bj][0] * acc[ai][bj][m][0], x1 * DN_ALPHA + gv[bj][1] * acc[ai][bj][m][1]); }
                off += (size_t)16 * D; asm volatile("" : "+v"(off)); }
            off += (size_t)(HALF - 64) * D; }
    }
};
struct EpiRouter {
    static constexpr bool PERM = false, MIDHOOK = false;
    float* L;
    DI void operator()(const Acc& acc, const Unit& u, int wr, int wc, int fr, int fq) const {
        if (wc >= 2) return;
        const int row0 = u.pm * BM + wr * 64 + fr, col0 = wc * 32 + 4 * fq;
#pragma unroll
        for (int ai = 0; ai < 2; ++ai)
#pragma unroll
            for (int m = 0; m < 4; ++m) { float* rp = L + (size_t)(row0 + ai * HALF + m * 16) * 64 + col0;
#pragma unroll
                for (int n = 0; n < 2; ++n) *(f32x4*)(rp + n * 16) = acc[ai][0][m][n]; }
    }
};
struct EpiGU {
    static constexpr bool PERM = true, MIDHOOK = false;
    bf16_t* H;
    DI void operator()(const Acc& acc, const Unit& u, int wr, int wc, int fr, int fq) const {
        const int row0 = u.pm * BM + wr * 64 + fr, col0 = u.pn * HALF + wc * 32 + 8 * fq;
        bf16_t* rp = H + (size_t)row0 * 256 + col0;
#pragma unroll
        for (int ai = 0; ai < 2; ++ai) {
#pragma unroll
            for (int m = 0; m < 4; ++m) { f32x4 v[2];
#pragma unroll
                for (int n = 0; n < 2; ++n) { const f32x4 gt = acc[ai][0][m][n], up = acc[ai][1][m][n];
#pragma unroll
                    for (int j = 0; j < 4; ++j) v[n][j] = gt[j] * fast_sigmoid(gt[j]) * up[j]; }
                *(u32x4*)rp = pack8(v[0], v[1]); rp += 16 * 256; asm volatile("" : "+v"(rp)); }
            rp += (HALF - 64) * 256; }
    }
};
struct EpiSlotF8 {
    static constexpr bool PERM = true, MIDHOOK = false;
    unsigned char* O;
    DI void operator()(const Acc& acc, const Unit& u, int wr, int wc, int fr, int fq) const {
        if (O == nullptr) return;
        const int row0 = u.pm * BM + wr * 64 + fr;
        unsigned char* rowp = O + (size_t)row0 * 1024 + u.pn * 256 + (wc * 4 + fq) * 16;
#pragma unroll
        for (int ai = 0; ai < 2; ++ai) {
#pragma unroll
            for (int m = 0; m < 4; ++m) {
                u32x4 w;
#pragma unroll
                for (int bj = 0; bj < 2; ++bj)
#pragma unroll
                    for (int n = 0; n < 2; ++n) { const f32x4 v = acc[ai][bj][m][n] * SLOT_SCALE;
                        int t = __builtin_amdgcn_cvt_pk_fp8_f32(v[0], v[1], 0, false); t = __builtin_amdgcn_cvt_pk_fp8_f32(v[2], v[3], t, true);
                        w[bj * 2 + n] = (unsigned)t; }
                __builtin_nontemporal_store(w, (u32x4*)rowp);
                rowp += (size_t)16 * 1024; asm volatile("" : "+v"(rowp)); }
            rowp += (size_t)(HALF - 64) * 1024; }
    }
};
struct EpiPlain {
    static constexpr bool PERM = true, MIDHOOK = false;
    bf16_t* O; int ldc;
    DI void operator()(const Acc& acc, const Unit& u, int wr, int wc, int fr, int fq) const {
        if (O == nullptr) return;
        const int row0 = u.pm * BM + wr * 64 + fr, col0 = u.pn * BM + wc * 32 + 8 * fq;
        bf16_t* rowp = O + (size_t)row0 * ldc + col0;
#pragma unroll
        for (int ai = 0; ai < 2; ++ai) {
#pragma unroll
            for (int m = 0; m < 4; ++m) {
#pragma unroll
                for (int bj = 0; bj < 2; ++bj) __builtin_nontemporal_store(pack8(acc[ai][bj][m][0], acc[ai][bj][m][1]), (u32x4*)(rowp + bj * HALF));
                rowp += (size_t)16 * ldc; asm volatile("" : "+v"(rowp)); }
            rowp += (size_t)(HALF - 64) * ldc; }
    }
};
}

namespace att {
constexpr int TILE_B = 8192, GRP_BUF = 2 * TILE_B, NBUF = 6, PD = 4;
constexpr int ATT_LDS = NBUF * GRP_BUF;
constexpr int BIAS_OFF = ATT_LDS;
constexpr int QBUF_OFF = BIAS_OFF + 8192;
static_assert(QBUF_OFF + 8 * 4096 <= RING_BYTES, "attention LDS map");
struct Sub { int qbase, qstr, k0, kstr, nkt, koff, maxd; };
#define MFMA32(a, b, c) __builtin_amdgcn_mfma_f32_32x32x16_bf16((a), (b), (c), 0, 0, 0)
#define ATT_BAR() do { asm volatile("s_waitcnt lgkmcnt(0)" ::: "memory"); __builtin_amdgcn_s_barrier(); asm volatile("" ::: "memory"); } while (0)

DI float max_xor32(float v) { float p = v, q = v; asm volatile("s_nop 1\n\tv_permlane32_swap_b32 %0, %1\n\ts_nop 1" : "+v"(p), "+v"(q)); return fmaxf(p, q); }
DI void half_swap(unsigned& a, unsigned& b) { asm volatile("s_nop 1\n\tv_permlane32_swap_b32 %0, %1\n\ts_nop 1" : "+v"(a), "+v"(b)); }
DI u32x4 pair16(const u32x2 ga, const u32x2 gb) { unsigned a0 = ga.x, a1 = ga.y, b0 = gb.x, b1 = gb.y; half_swap(a0, b0); half_swap(a1, b1); return (u32x4){a0, a1, b0, b1}; }
DI void unpair16(const u32x4 w, u32x2& ga, u32x2& gb) { unsigned x0 = w.x, x1 = w.y, x2 = w.z, x3 = w.w; half_swap(x0, x2); half_swap(x1, x3); ga = (u32x2){x0, x1}; gb = (u32x2){x2, x3}; }
DI f32x16 cat16(f32x4 a, f32x4 b, f32x4 c, f32x4 d) {
    typedef float f32x8_ __attribute__((ext_vector_type(8)));
    const f32x8_ ab = __builtin_shufflevector(a, b, 0, 1, 2, 3, 4, 5, 6, 7), cd = __builtin_shufflevector(c, d, 0, 1, 2, 3, 4, 5, 6, 7);
    return __builtin_shufflevector(ab, cd, 0, 1, 2, 3, 4, 5, 6, 7, 8, 9, 10, 11, 12, 13, 14, 15);
}
DI bf16x8 pack_step8(float a0, float a1, float a2, float a3, float a4, float a5, float a6, float a7) {
    u32x4 p; p.x = cvt_pk_bf16(a0, a1); p.y = cvt_pk_bf16(a2, a3); p.z = cvt_pk_bf16(a4, a5); p.w = cvt_pk_bf16(a6, a7);
    return __builtin_bit_cast(bf16x8, p);
}
struct GSub { int qbase, qstr, koff, maxd, lo, hi; };
struct GenFox { int b; static constexpr int A = 1;
    DI int nt(int u) const { return 4 * u + 4; }
    DI int kstr() const { return 1; }
    DI int tile_k0(int, int j) const { return b * SEQ + 64 * j; }
    DI GSub sub(int u, int grp) const { GSub s; const int qb = 2 * u + grp; s.qbase = b * SEQ + 128 * qb; s.qstr = 1; s.koff = 128 * qb; s.maxd = 1 << 30; s.lo = 0; s.hi = 2 * qb + 2; return s; } };
struct GenDil { int b, dl, nblk; static constexpr int A = 1;
    DI int kstr() const { return dl; }
    DI int nt(int u) const { if (nblk == 1) return 4; const int n = (2 * u) % nblk; return n == 0 ? 4 : 6; }
    DI int tile_k0(int u, int j) const {
        if (nblk == 1) return b * SEQ + (2 * u + (j >> 1)) + 64 * (j & 1) * dl;
        const int su = 2 * u, cls = su / nblk, n = su % nblk; const int first = (n == 0) ? 0 : 2 * n - 2;
        return b * SEQ + cls + 64 * (first + j) * dl; }
    DI GSub sub(int u, int grp) const { GSub t; t.qstr = dl; t.maxd = 128;
        if (nblk == 1) { t.qbase = b * SEQ + 2 * u + grp; t.koff = 0; t.lo = 2 * grp; t.hi = 2 * grp + 2; return t; }
        const int su = 2 * u, cls = su / nblk, n = su % nblk + grp;
        t.qbase = b * SEQ + cls + 128 * n * dl;
        if (n == 0) { t.koff = 0; t.lo = 0; t.hi = 2; } else if (n == 1) { t.koff = 128; t.lo = 0; t.hi = 4; } else { t.koff = 128; t.lo = 2 * grp; t.hi = 2 * grp + 4; }
        return t; } };

struct GenDil2 { int b, dl, nblk; static constexpr int A = 2;
    DI int kstr() const { return dl; }
    DI int nt(int) const { return nblk == 1 ? 2 : 4; }
    DI int tile2(int u, int s, int g) const {
        if (nblk == 1) return b * SEQ + (2 * u + g) + 64 * s * dl;
        const int su = 2 * u, cls = su / nblk, n = su % nblk + g; const int tile = (n == 0) ? s : 2 * n - 2 + s;
        return b * SEQ + cls + 64 * tile * dl; }
    DI GSub sub(int u, int grp) const { GSub t; t.qstr = dl; t.maxd = 128; t.lo = 0;
        if (nblk == 1) { t.qbase = b * SEQ + 2 * u + grp; t.koff = 0; t.hi = 2; return t; }
        const int su = 2 * u, cls = su / nblk, n = su % nblk + grp;
        t.qbase = b * SEQ + cls + 128 * n * dl; t.koff = (n == 0) ? 0 : 128; t.hi = (n == 0) ? 2 : 4; return t; } };

template <int MODE, class Gen, int NU>
__device__ __forceinline__ void attn_pass(LAS unsigned char* ring, const Gen gen, const bf16_t* qT, const bf16_t* kT, const bf16_t* vT,

                                          bf16_t* Y, const int ycol, bf16_t* part_w, float* lse_w, const bf16_t* part_a, const bf16_t* part_b, const float* lse_a, const float* lse_b, const int head, const int var) {
    const int tid = fresh_tid(), wid = __builtin_amdgcn_readfirstlane(tid >> 6), lane = tid & 63, grp = wid >> 2, wq = wid & 3;
    const int r = lane & 31, hh = lane >> 5;
    const LAS float* bias2 = (const LAS float*)(ring + BIAS_OFF);
    const int qi = 32 * wq + r;
    const unsigned q4 = (unsigned)((lane & 15) >> 2), p4 = (unsigned)(lane & 3), blk = (unsigned)((lane >> 4) & 1);
    GSub sb = gen.sub(0, grp);
    bf16x8 qf[4];
    LAS unsigned char* qbuf = ring + QBUF_OFF + wid * 4096;
    int fill = 0, rd = 0;
    const unsigned kx0 = (unsigned)(r * 128 + (((0 + hh) ^ ((r >> 1) & 7)) * 16)), kx1 = (unsigned)(r * 128 + (((2 + hh) ^ ((r >> 1) & 7)) * 16)),
                   kx2 = (unsigned)(r * 128 + (((4 + hh) ^ ((r >> 1) & 7)) * 16)), kx3 = (unsigned)(r * 128 + (((6 + hh) ^ ((r >> 1) & 7)) * 16));
    const int kstr = gen.kstr();
#define ATT_ISSUE(TOK0) do { LAS unsigned char* fb_ = ring + fill * GRP_BUF; \
        const int kc_ = (lane & 7) ^ ((4 * wid + (lane >> 4)) & 7); \
        const bf16_t* kp_ = kT + (size_t)((TOK0) + (8 * wid + (lane >> 3)) * kstr + (kc_ >> 2) * SEQ) * 32 + (kc_ & 3) * 8; \
        const bf16_t* vp_ = vT + (size_t)((TOK0) + (16 * (wid & 3) + (lane >> 2)) * kstr + (wid >> 2) * SEQ) * 32 + (lane & 3) * 8; \
        __builtin_amdgcn_global_load_lds((const unsigned*)kp_, (LAS unsigned*)(fb_ + wid * 1024), 16, 0, 0); \
        __builtin_amdgcn_global_load_lds((const unsigned*)vp_, (LAS unsigned*)(fb_ + TILE_B + (wid >> 2) * 4096 + (wid & 3) * 1024), 16, 0, 0); \
        fill = (fill == NBUF - 1) ? 0 : fill + 1; } while (0)
#define ATT_QISSUE(S_) do { const bf16_t* qp_ = qT + (size_t)((S_).qbase + qi * (S_).qstr) * 32 + 8 * hh; \
        _Pragma("unroll") for (int s_ = 0; s_ < 4; ++s_) __builtin_amdgcn_global_load_lds((const unsigned*)(qp_ + (size_t)(s_ >> 1) * SEQ * 32 + 16 * (s_ & 1)), (LAS unsigned*)(qbuf + s_ * 1024), 16, 0, 0); } while (0)
    constexpr int A = Gen::A;
    ATT_QISSUE(sb);
    if constexpr (A == 2) {
#pragma unroll
        for (int j = 0; j < 4; ++j) ATT_ISSUE(gen.tile2(0, j >> 1, j & 1));
        asm volatile("s_waitcnt vmcnt(4)" ::: "memory");
    } else {
#pragma unroll
        for (int j = 0; j < PD; ++j) ATT_ISSUE(gen.tile_k0(0, j));
        asm volatile("s_waitcnt vmcnt(6)" ::: "memory");
    }
    ATT_BAR();
    if (grp == 1) __builtin_amdgcn_s_barrier();
#pragma unroll 1
    for (int u = 0; u < NU; ++u) {
        const int nt = gen.nt(u);
        const bool has_nu = (u + 1 < NU);
        GSub nsb = sb; if (has_nu) nsb = gen.sub(u + 1, grp);
#pragma unroll
        for (int s = 0; s < 4; ++s) qf[s] = *(const LAS bf16x8*)(qbuf + s * 1024 + lane * 16);
        asm volatile("s_waitcnt lgkmcnt(0)" : "+v"(qf[0]), "+v"(qf[1]), "+v"(qf[2]), "+v"(qf[3]) :: "memory");
        f32x16 o0, o1;
#pragma unroll
        for (int i = 0; i < 16; ++i) { o0[i] = 0.f; o1[i] = 0.f; }
        float mrun = NEGBIG, lsum = 0.f;
        u32x4 pla[2][2], plb[2][2]; float pl2 = 0.f, pl3 = 0.f;
#pragma unroll 1
        for (int kt = 0; kt < nt; ++kt) {
            const int ktl = kt - sb.lo;
            const bool inwin = (var != 3) && (var != 5) && (kt >= sb.lo) && (kt < sb.hi);
            const int dh0 = 32 * wq + 31 + sb.koff - ktl * 64, dl0 = dh0 - 62, dh1 = dh0 - 32, dl1 = dl0 - 32;
            const bool act0 = inwin && (dh0 >= 0) && (dl0 <= sb.maxd), act1 = inwin && (dh1 >= 0) && (dl1 <= sb.maxd);
            const bool full0 = (dl0 >= 0) && (dh0 <= sb.maxd), full1 = (dl1 >= 0) && (dh1 <= sb.maxd);
            const bool both = act0 && act1;
            f32x16 s0, s1; s16x4 vt[16];
            const LAS unsigned char* Kt = ring + (rd + (A == 2 ? grp : 0)) * GRP_BUF; const LAS unsigned char* Vt = Kt + TILE_B;
            const unsigned vbase = (unsigned)(uintptr_t)Vt + (unsigned)(4 * hh + (int)q4) * 64u + 32u * blk + 8u * p4;
            const int dbase = qi + sb.koff - ktl * 64;
            float mx = NEGBIG;
#define ATT_STEP_ISSUE() do { if constexpr (A == 2) { \
                if (kt + 2 < nt) { ATT_ISSUE(gen.tile2(u, kt + 2, 0)); ATT_ISSUE(gen.tile2(u, kt + 2, 1)); } \
                else if (has_nu) { if (kt + 2 == nt) ATT_QISSUE(nsb); ATT_ISSUE(gen.tile2(u + 1, kt + 2 - nt, 0)); ATT_ISSUE(gen.tile2(u + 1, kt + 2 - nt, 1)); } } \
            else { if (kt + PD < nt) { ATT_ISSUE(gen.tile_k0(u, kt + PD)); } \
            else if (has_nu) { if (kt + PD == nt) ATT_QISSUE(nsb);                      \
                ATT_ISSUE(gen.tile_k0(u + 1, kt + PD - nt)); } } } while (0)
            bf16x8 kfa[4], kfb[4]; f32x4 bza[4], bzb[4];
            if (both) {
                const unsigned kb_ = (unsigned)(uintptr_t)Kt;
                if (MODE == 0) { const unsigned ba_ = (unsigned)(uintptr_t)bias2 + (unsigned)(kt * 64 + 4 * hh) * 4u;
                    asm volatile("ds_read_b128 %0, %4\n\tds_read_b128 %1, %4 offset:32\n\tds_read_b128 %2, %4 offset:64\n\tds_read_b128 %3, %4 offset:96"
                                 : "=&v"(bza[0]), "=&v"(bza[1]), "=&v"(bza[2]), "=&v"(bza[3]) : "v"(ba_) : "memory"); }
                asm volatile("ds_read_b128 %0, %8\n\tds_read_b128 %1, %9\n\tds_read_b128 %2, %10\n\tds_read_b128 %3, %11\n\t"
                             "ds_read_b128 %4, %8 offset:4096\n\tds_read_b128 %5, %9 offset:4096\n\tds_read_b128 %6, %10 offset:4096\n\tds_read_b128 %7, %11 offset:4096"
                             : "=&v"(kfa[0]), "=&v"(kfa[1]), "=&v"(kfa[2]), "=&v"(kfa[3]), "=&v"(kfb[0]), "=&v"(kfb[1]), "=&v"(kfb[2]), "=&v"(kfb[3])
                             : "v"(kb_ + kx0), "v"(kb_ + kx1), "v"(kb_ + kx2), "v"(kb_ + kx3) : "memory");
                if (MODE == 0) {
                    asm volatile("s_waitcnt lgkmcnt(4)" : "+v"(kfa[0]), "+v"(kfa[1]), "+v"(kfa[2]), "+v"(kfa[3]), "+v"(bza[0]), "+v"(bza[1]), "+v"(bza[2]), "+v"(bza[3]) :: "memory");
                    s0 = cat16(bza[0], bza[1], bza[2], bza[3]);
                } else {
                    asm volatile("s_waitcnt lgkmcnt(4)" : "+v"(kfa[0]), "+v"(kfa[1]), "+v"(kfa[2]), "+v"(kfa[3]) :: "memory");
#pragma unroll
                    for (int i = 0; i < 16; ++i) s0[i] = 0.f;
                }
#pragma unroll
                for (int s = 0; s < 4; ++s) s0 = MFMA32(kfa[s], qf[s], s0);
                if (MODE == 0) { const unsigned ba_ = (unsigned)(uintptr_t)bias2 + (unsigned)(kt * 64 + 4 * hh) * 4u;
                    asm volatile("ds_read_b128 %0, %4 offset:128\n\tds_read_b128 %1, %4 offset:160\n\tds_read_b128 %2, %4 offset:192\n\tds_read_b128 %3, %4 offset:224"
                                 : "=&v"(bzb[0]), "=&v"(bzb[1]), "=&v"(bzb[2]), "=&v"(bzb[3]) : "v"(ba_) : "memory"); }
                asm volatile(
                    "ds_read_b64_tr_b16 %0, %8 offset:0\n\tds_read_b64_tr_b16 %1, %8 offset:512\n\tds_read_b64_tr_b16 %2, %8 offset:1024\n\tds_read_b64_tr_b16 %3, %8 offset:1536\n\t"
                    "ds_read_b64_tr_b16 %4, %8 offset:4096\n\tds_read_b64_tr_b16 %5, %8 offset:4608\n\tds_read_b64_tr_b16 %6, %8 offset:5120\n\tds_read_b64_tr_b16 %7, %8 offset:5632"
                    : "=&v"(vt[0]), "=&v"(vt[1]), "=&v"(vt[2]), "=&v"(vt[3]), "=&v"(vt[8]), "=&v"(vt[9]), "=&v"(vt[10]), "=&v"(vt[11]) : "v"(vbase) : "memory");
                if (MODE == 0) {
                    asm volatile("s_waitcnt lgkmcnt(8)" : "+v"(kfb[0]), "+v"(kfb[1]), "+v"(kfb[2]), "+v"(kfb[3]), "+v"(bzb[0]), "+v"(bzb[1]), "+v"(bzb[2]), "+v"(bzb[3]) :: "memory");
                    s1 = cat16(bzb[0], bzb[1], bzb[2], bzb[3]);
                } else {
                    asm volatile("s_waitcnt lgkmcnt(8)" : "+v"(kfb[0]), "+v"(kfb[1]), "+v"(kfb[2]), "+v"(kfb[3]) :: "memory");
#pragma unroll
                    for (int i = 0; i < 16; ++i) s1[i] = 0.f;
                }
#pragma unroll
                for (int s = 0; s < 4; ++s) s1 = MFMA32(kfb[s], qf[s], s1);
                asm volatile(
                    "ds_read_b64_tr_b16 %0, %8 offset:2048\n\tds_read_b64_tr_b16 %1, %8 offset:2560\n\tds_read_b64_tr_b16 %2, %8 offset:3072\n\tds_read_b64_tr_b16 %3, %8 offset:3584\n\t"
                    "ds_read_b64_tr_b16 %4, %8 offset:6144\n\tds_read_b64_tr_b16 %5, %8 offset:6656\n\tds_read_b64_tr_b16 %6, %8 offset:7168\n\tds_read_b64_tr_b16 %7, %8 offset:7680"
                    : "=&v"(vt[4]), "=&v"(vt[5]), "=&v"(vt[6]), "=&v"(vt[7]), "=&v"(vt[12]), "=&v"(vt[13]), "=&v"(vt[14]), "=&v"(vt[15]) : "v"(vbase) : "memory");
                if (!full0) {
#pragma unroll
                    for (int i = 0; i < 16; ++i) { const int kr = (i & 3) + 8 * (i >> 2) + 4 * hh; if ((unsigned)(dbase - kr) > (unsigned)sb.maxd) s0[i] = NEGBIG; }
                }
                float mxa = NEGBIG, mxb = NEGBIG;
#pragma unroll
                for (int i = 0; i < 16; ++i) mxa = fmaxf(mxa, s0[i]);
                if (!full1) {
#pragma unroll
                    for (int i = 0; i < 16; ++i) { const int kr = (i & 3) + 8 * (i >> 2) + 4 * hh; if ((unsigned)(dbase - kr - 32) > (unsigned)sb.maxd) s1[i] = NEGBIG; }
                }
#pragma unroll
                for (int i = 0; i < 16; ++i) mxb = fmaxf(mxb, s1[i]);
                mx = fmaxf(mxa, mxb);
            }
            if (act0 && !both) {
                if (MODE == 0) {
#pragma unroll
                    for (int g4 = 0; g4 < 4; ++g4) { const f32x4 b0 = *(const LAS f32x4*)(bias2 + kt * 64 + 8 * g4 + 4 * hh);
#pragma unroll
                        for (int j = 0; j < 4; ++j) s0[4 * g4 + j] = b0[j]; }
                } else {
#pragma unroll
                    for (int i = 0; i < 16; ++i) s0[i] = 0.f;
                }
#pragma unroll
                for (int s = 0; s < 4; ++s) { const bf16x8 kf = *(const LAS bf16x8*)(Kt + r * 128 + (((2 * s + hh) ^ ((r >> 1) & 7)) * 16)); s0 = MFMA32(kf, qf[s], s0); }
                asm volatile(
                    "ds_read_b64_tr_b16 %0, %8 offset:0\n\tds_read_b64_tr_b16 %1, %8 offset:512\n\tds_read_b64_tr_b16 %2, %8 offset:1024\n\tds_read_b64_tr_b16 %3, %8 offset:1536\n\t"
                    "ds_read_b64_tr_b16 %4, %8 offset:4096\n\tds_read_b64_tr_b16 %5, %8 offset:4608\n\tds_read_b64_tr_b16 %6, %8 offset:5120\n\tds_read_b64_tr_b16 %7, %8 offset:5632"
                    : "=&v"(vt[0]), "=&v"(vt[1]), "=&v"(vt[2]), "=&v"(vt[3]), "=&v"(vt[8]), "=&v"(vt[9]), "=&v"(vt[10]), "=&v"(vt[11]) : "v"(vbase) : "memory");
                if (!full0) {
#pragma unroll
                    for (int i = 0; i < 16; ++i) { const int kr = (i & 3) + 8 * (i >> 2) + 4 * hh; if ((unsigned)(dbase - kr) > (unsigned)sb.maxd) s0[i] = NEGBIG; }
                }
#pragma unroll
                for (int i = 0; i < 16; ++i) mx = fmaxf(mx, s0[i]);
            }
            if (act1 && !both) {
                if (MODE == 0) {
#pragma unroll
                    for (int g4 = 0; g4 < 4; ++g4) { const f32x4 b1 = *(const LAS f32x4*)(bias2 + kt * 64 + 32 + 8 * g4 + 4 * hh);
#pragma unroll
                        for (int j = 0; j < 4; ++j) s1[4 * g4 + j] = b1[j]; }
                } else {
#pragma unroll
                    for (int i = 0; i < 16; ++i) s1[i] = 0.f;
                }
#pragma unroll
                for (int s = 0; s < 4; ++s) { const bf16x8 kf = *(const LAS bf16x8*)(Kt + (32 + r) * 128 + (((2 * s + hh) ^ ((r >> 1) & 7)) * 16)); s1 = MFMA32(kf, qf[s], s1); }
                asm volatile(
                    "ds_read_b64_tr_b16 %0, %8 offset:2048\n\tds_read_b64_tr_b16 %1, %8 offset:2560\n\tds_read_b64_tr_b16 %2, %8 offset:3072\n\tds_read_b64_tr_b16 %3, %8 offset:3584\n\t"
                    "ds_read_b64_tr_b16 %4, %8 offset:6144\n\tds_read_b64_tr_b16 %5, %8 offset:6656\n\tds_read_b64_tr_b16 %6, %8 offset:7168\n\tds_read_b64_tr_b16 %7, %8 offset:7680"
                    : "=&v"(vt[4]), "=&v"(vt[5]), "=&v"(vt[6]), "=&v"(vt[7]), "=&v"(vt[12]), "=&v"(vt[13]), "=&v"(vt[14]), "=&v"(vt[15]) : "v"(vbase) : "memory");
                if (!full1) {
#pragma unroll
                    for (int i = 0; i < 16; ++i) { const int kr = (i & 3) + 8 * (i >> 2) + 4 * hh; if ((unsigned)(dbase - kr - 32) > (unsigned)sb.maxd) s1[i] = NEGBIG; }
                }
#pragma unroll
                for (int i = 0; i < 16; ++i) mx = fmaxf(mx, s1[i]);
            }
            if (act0 || act1) {
                mx = max_xor32(mx);
                if (__builtin_amdgcn_ballot_w64(mx - mrun > 6.0f) != 0ull) {
                    const float mnew = fmaxf(mrun, mx), alpha = __builtin_amdgcn_exp2f(mrun - mnew);
                    mrun = mnew; lsum *= alpha;
#pragma unroll
                    for (int i = 0; i < 16; ++i) { o0[i] *= alpha; o1[i] *= alpha; }
                }
            }
            if constexpr (A == 2) {
                if (MODE == 1 && u > 0 && kt == 0) asm volatile("s_waitcnt vmcnt(8)" ::: "memory");
                else asm volatile("s_waitcnt vmcnt(0)" ::: "memory");
            } else
            {   int allow = 0;
                if (kt + 2 < nt || has_nu) allow += 2;
                if (kt + 3 < nt || has_nu) allow += 2;
                if (has_nu && (nt == kt + 2 || nt == kt + 3)) allow += 4;
                if (MODE != 2 && u > 0 && kt < 3) allow += 8;
                if (allow == 4) asm volatile("s_waitcnt vmcnt(4)" ::: "memory"); else if (allow == 12) asm volatile("s_waitcnt vmcnt(12)" ::: "memory");
                else if (allow == 8) asm volatile("s_waitcnt vmcnt(8)" ::: "memory"); else if (allow == 16) asm volatile("s_waitcnt vmcnt(16)" ::: "memory");
                else if (allow == 10) asm volatile("s_waitcnt vmcnt(10)" ::: "memory"); else if (allow == 2) asm volatile("s_waitcnt vmcnt(2)" ::: "memory");
                else asm volatile("s_waitcnt vmcnt(0)" ::: "memory"); }
            __builtin_amdgcn_s_barrier(); asm volatile("" ::: "memory");
            ATT_STEP_ISSUE();
            if (MODE == 2 && kt == nt - 2) {
                const size_t qt_ = (size_t)(sb.qbase + qi * sb.qstr);
                const bf16_t* pa_ = part_a + qt_ * 512 + head * 64 + 8 * hh; const bf16_t* pb_ = part_b + qt_ * 512 + head * 64 + 8 * hh;
#pragma unroll
                for (int p = 0; p < 2; ++p) { pla[p][0] = *(const u32x4*)(pa_ + 16 * p); pla[p][1] = *(const u32x4*)(pa_ + 32 + 16 * p); plb[p][0] = *(const u32x4*)(pb_ + 16 * p); plb[p][1] = *(const u32x4*)(pb_ + 32 + 16 * p); }
                pl2 = lse_a[qt_ * 8 + head]; pl3 = lse_b[qt_ * 8 + head];
            }
#define VFR(i) __builtin_shufflevector(vt[2 * (i)], vt[2 * (i) + 1], 0, 1, 2, 3, 4, 5, 6, 7)
            if (act0) {
                float ps = 0.f;
#pragma unroll
                for (int i = 0; i < 16; ++i) { s0[i] = __builtin_amdgcn_exp2f(s0[i] - mrun); ps += s0[i]; }
                lsum += ps;
                const bf16x8 p00 = pack_step8(s0[0], s0[1], s0[2], s0[3], s0[4], s0[5], s0[6], s0[7]);
                const bf16x8 p01 = pack_step8(s0[8], s0[9], s0[10], s0[11], s0[12], s0[13], s0[14], s0[15]);
                asm volatile("s_waitcnt lgkmcnt(0)" : "+v"(vt[0]), "+v"(vt[1]), "+v"(vt[2]), "+v"(vt[3]), "+v"(vt[8]), "+v"(vt[9]), "+v"(vt[10]), "+v"(vt[11]) :: "memory");
                o0 = MFMA32(VFR(0), p00, o0); o0 = MFMA32(VFR(1), p01, o0);
                o1 = MFMA32(VFR(4), p00, o1); o1 = MFMA32(VFR(5), p01, o1);
            }
            if (act1) {
                float ps = 0.f;
#pragma unroll
                for (int i = 0; i < 16; ++i) { s1[i] = __builtin_amdgcn_exp2f(s1[i] - mrun); ps += s1[i]; }
                lsum += ps;
                const bf16x8 p10 = pack_step8(s1[0], s1[1], s1[2], s1[3], s1[4], s1[5], s1[6], s1[7]);
                const bf16x8 p11 = pack_step8(s1[8], s1[9], s1[10], s1[11], s1[12], s1[13], s1[14], s1[15]);
                asm volatile("s_waitcnt lgkmcnt(0)" : "+v"(vt[4]), "+v"(vt[5]), "+v"(vt[6]), "+v"(vt[7]), "+v"(vt[12]), "+v"(vt[13]), "+v"(vt[14]), "+v"(vt[15]) :: "memory");
                o0 = MFMA32(VFR(2), p10, o0); o0 = MFMA32(VFR(3), p11, o0);
                o1 = MFMA32(VFR(6), p10, o1); o1 = MFMA32(VFR(7), p11, o1);
            }
#undef VFR
            rd += A; if (rd >= NBUF) rd -= NBUF;
            ATT_BAR();
        }
        if (var >= 4) { sb = nsb; continue; }
        const size_t qtok = (size_t)(sb.qbase + qi * sb.qstr);
        const float ltot = lsum + __shfl_xor(lsum, 32);
        const float inv = 1.0f / ltot;
        if (MODE == 0) {
            bf16_t* op = Y + qtok * D + ycol + 4 * hh;
#pragma unroll
            for (int g4 = 0; g4 < 4; ++g4) {
                u32x2 w0; w0.x = cvt_pk_bf16(o0[4 * g4] * inv, o0[4 * g4 + 1] * inv); w0.y = cvt_pk_bf16(o0[4 * g4 + 2] * inv, o0[4 * g4 + 3] * inv);
                u32x2 w1; w1.x = cvt_pk_bf16(o1[4 * g4] * inv, o1[4 * g4 + 1] * inv); w1.y = cvt_pk_bf16(o1[4 * g4 + 2] * inv, o1[4 * g4 + 3] * inv);
                *(u32x2*)(op + 8 * g4) = w0; *(u32x2*)(op + 32 + 8 * g4) = w1; }
        } else if (MODE == 1) {
            bf16_t* op = part_w + qtok * 512 + head * 64 + 8 * hh;
#pragma unroll
            for (int p = 0; p < 2; ++p) {
                u32x2 wa[2], wb[2];
#pragma unroll
                for (int q = 0; q < 2; ++q) { const int g4 = 2 * p + q;
                    wa[q].x = cvt_pk_bf16(o0[4 * g4] * inv, o0[4 * g4 + 1] * inv); wa[q].y = cvt_pk_bf16(o0[4 * g4 + 2] * inv, o0[4 * g4 + 3] * inv);
                    wb[q].x = cvt_pk_bf16(o1[4 * g4] * inv, o1[4 * g4 + 1] * inv); wb[q].y = cvt_pk_bf16(o1[4 * g4 + 2] * inv, o1[4 * g4 + 3] * inv); }
                *(u32x4*)(op + 16 * p) = pair16(wa[0], wa[1]); *(u32x4*)(op + 32 + 16 * p) = pair16(wb[0], wb[1]); }
            if (hh == 0) lse_w[qtok * 8 + head] = mrun + __builtin_amdgcn_logf(ltot);
        } else {
            const float l1 = mrun + __builtin_amdgcn_logf(ltot), l2 = pl2, l3 = pl3;
            const float M = fmaxf(l1, fmaxf(l2, l3));
            float w1 = __builtin_amdgcn_exp2f(l1 - M), w2 = __builtin_amdgcn_exp2f(l2 - M), w3 = __builtin_amdgcn_exp2f(l3 - M);
            const float wi = 1.0f / (w1 + w2 + w3); w1 *= wi * inv; w2 *= wi; w3 *= wi;
            bf16_t* op = Y + qtok * D + ycol + 8 * hh;
#pragma unroll
            for (int p = 0; p < 2; ++p) {
                const u32x4 la0 = pla[p][0], la1 = pla[p][1], lb0 = plb[p][0], lb1 = plb[p][1];
                u32x2 a0[2], a1[2], b0[2], b1[2];
                unpair16(la0, a0[0], a0[1]); unpair16(la1, a1[0], a1[1]); unpair16(lb0, b0[0], b0[1]); unpair16(lb1, b1[0], b1[1]);
                u32x2 wa[2], wb[2];
#pragma unroll
                for (int q = 0; q < 2; ++q) { const int g4 = 2 * p + q;
                    wa[q].x = cvt_pk_bf16(o0[4 * g4] * w1 + bf_lo(a0[q].x) * w2 + bf_lo(b0[q].x) * w3, o0[4 * g4 + 1] * w1 + bf_hi(a0[q].x) * w2 + bf_hi(b0[q].x) * w3);
                    wa[q].y = cvt_pk_bf16(o0[4 * g4 + 2] * w1 + bf_lo(a0[q].y) * w2 + bf_lo(b0[q].y) * w3, o0[4 * g4 + 3] * w1 + bf_hi(a0[q].y) * w2 + bf_hi(b0[q].y) * w3);
                    wb[q].x = cvt_pk_bf16(o1[4 * g4] * w1 + bf_lo(a1[q].x) * w2 + bf_lo(b1[q].x) * w3, o1[4 * g4 + 1] * w1 + bf_hi(a1[q].x) * w2 + bf_hi(b1[q].x) * w3);
                    wb[q].y = cvt_pk_bf16(o1[4 * g4 + 2] * w1 + bf_lo(a1[q].y) * w2 + bf_lo(b1[q].y) * w3, o1[4 * g4 + 3] * w1 + bf_hi(a1[q].y) * w2 + bf_hi(b1[q].y) * w3); }
                *(u32x4*)(op + 16 * p) = pair16(wa[0], wa[1]); *(u32x4*)(op + 32 + 16 * p) = pair16(wb[0], wb[1]); }
        }
        sb = nsb;
    }
    if (grp == 0) __builtin_amdgcn_s_barrier();
#undef ATT_STEP_ISSUE
#undef ATT_ISSUE
#undef ATT_QISSUE
}
namespace fx {
constexpr int NW=8,QBLK=32,QB=QBLK*NW,KVBLK=64;
__device__ __forceinline__ int crow(int r,int hi){return (r&3)+8*(r>>2)+4*hi;}
#define SBAR() __builtin_amdgcn_sched_barrier(0)
__device__ __forceinline__ void cmask(f32x16&p0,f32x16&p1,int jb,int qrel,int hi){
  const float NEG=-__builtin_inff(); int kb=64*jb+4*hi;
  #pragma unroll
  for(int r=0;r<16;++r){int kv=kb+(r&3)+8*(r>>2); if(kv>qrel)p0[r]=NEG; if(kv+32>qrel)p1[r]=NEG;}
}
constexpr int NSLOT=3, SLOTB=8192;
constexpr int LDS_K=0, LDS_V=NSLOT*SLOTB, LDS_WS=2*NSLOT*SLOTB, LDS_OST=LDS_WS+NW*64*4, LDS_BYTES=LDS_OST+NW*4096;
__device__ __forceinline__ void glds16(const void*gsrc,unsigned lds_dst){unsigned keep;
  asm volatile("s_mov_b32 %0, m0\n\ts_mov_b32 m0, %2\n\ts_nop 0\n\tglobal_load_lds_dwordx4 %1, off\n\ts_mov_b32 m0, %0":"=&s"(keep):"v"(gsrc),"s"(lds_dst):"memory");}
__device__ __forceinline__ float max3f(float a,float b,float c){float r;asm("v_max3_f32 %0, %1, %2, %3":"=v"(r):"v"(a),"v"(b),"v"(c));return r;}
__device__ __forceinline__ float max2f(float a,float b){float r;asm("v_max_f32_e32 %0, %1, %2":"=v"(r):"v"(a),"v"(b));return r;}
__device__ __forceinline__ float fadd_s(float a,float b){float r;asm("v_add_f32_e32 %0, %1, %2":"=v"(r):"v"(a),"v"(b));return r;}
__device__ __forceinline__ float fsub_s(float a,float b){float r;asm("v_sub_f32_e32 %0, %1, %2":"=v"(r):"v"(a),"v"(b));return r;}
typedef float f32x2_t __attribute__((ext_vector_type(2))); typedef __bf16 bf16x2_t __attribute__((ext_vector_type(2)));
__device__ __forceinline__ unsigned cvtpk_s(float lo,float hi){f32x2_t v={lo,hi};bf16x2_t b=__builtin_convertvector(v,bf16x2_t);return __builtin_bit_cast(unsigned,b);}
#define WAIT_BAR(N) asm volatile("s_waitcnt vmcnt(" #N ") lgkmcnt(0)\n\ts_barrier":::"memory")

typedef __attribute__((address_space(3))) const char* lds_cptr;
__device__ __forceinline__ void qkt(f32x16&p0,f32x16&p1,lds_cptr Kslot,const bf16x8*qr,int r32,int hi){
  const lds_cptr kb=Kslot+hi*1024+r32*16;
  #pragma unroll
  for(int d0=0;d0<4;++d0){
    const bf16x8 b0=*(const __attribute__((address_space(3))) bf16x8*)(kb+d0*2048);
    const bf16x8 b1=*(const __attribute__((address_space(3))) bf16x8*)(kb+d0*2048+512);
    p0=__builtin_amdgcn_mfma_f32_32x32x16_bf16(b0,qr[d0],p0,0,0,0);p1=__builtin_amdgcn_mfma_f32_32x32x16_bf16(b1,qr[d0],p1,0,0,0);}
}
typedef short v4i16_t __attribute__((ext_vector_type(4)));
__device__ __forceinline__ void kload8(bf16x8*kf,lds_cptr kp){
  kf[0]=*(const __attribute__((address_space(3))) bf16x8*)(kp);      kf[1]=*(const __attribute__((address_space(3))) bf16x8*)(kp+512);
  kf[2]=*(const __attribute__((address_space(3))) bf16x8*)(kp+2048); kf[3]=*(const __attribute__((address_space(3))) bf16x8*)(kp+2560);
  kf[4]=*(const __attribute__((address_space(3))) bf16x8*)(kp+4096); kf[5]=*(const __attribute__((address_space(3))) bf16x8*)(kp+4608);
  kf[6]=*(const __attribute__((address_space(3))) bf16x8*)(kp+6144); kf[7]=*(const __attribute__((address_space(3))) bf16x8*)(kp+6656);
}
__device__ __forceinline__ void kload2(bf16x8*kf,lds_cptr kp,int j){ kf[2*j]=*(const __attribute__((address_space(3))) bf16x8*)(kp+j*2048); kf[2*j+1]=*(const __attribute__((address_space(3))) bf16x8*)(kp+j*2048+512); }
__device__ __forceinline__ s16x4 vtr(lds_cptr p){ return __builtin_bit_cast(s16x4,__builtin_amdgcn_ds_read_tr16_b64_v4i16((__attribute__((address_space(3))) v4i16_t*)p)); }
__device__ __forceinline__ float rowmax(const f32x16&p0,const f32x16&p1){
  float a=max3f(p0[0],p0[1],p1[0]),b=max3f(p0[2],p0[3],p1[1]);a=max3f(a,p1[2],p1[3]);
  #pragma unroll
  for(int r=4;r<16;r+=4){a=max3f(a,p0[r],p0[r+1]);b=max3f(b,p0[r+2],p0[r+3]);a=max3f(a,p1[r],p1[r+1]);b=max3f(b,p1[r+2],p1[r+3]);}
  const float m=max2f(a,b);
  auto rr=__builtin_amdgcn_permlane32_swap(__float_as_uint(m),__float_as_uint(m),false,false);
  return max2f(__uint_as_float(rr[0]),__uint_as_float(rr[1]));
}
__device__ __forceinline__ void pv(f32x16*o,int vb,bf16x8 pa0,bf16x8 pa1,bf16x8 pa2,bf16x8 pa3){
  #pragma unroll
  for(int d0=0;d0<2;++d0){s16x4 lo[4],hi[4];
    #pragma unroll
    for(int ks=0;ks<4;++ks){
      asm volatile("ds_read_b64_tr_b16 %0,%1 offset:%c2":"=&v"(lo[ks]):"v"(vb),"i"(d0*4096+ks*1024):"memory");
      asm volatile("ds_read_b64_tr_b16 %0,%1 offset:%c2":"=&v"(hi[ks]):"v"(vb),"i"(d0*4096+ks*1024+512):"memory");}
    asm volatile("s_waitcnt lgkmcnt(0)":::"memory");SBAR();
    #define PK(k) (bf16x8){lo[k][0],lo[k][1],lo[k][2],lo[k][3],hi[k][0],hi[k][1],hi[k][2],hi[k][3]}
    o[d0]=__builtin_amdgcn_mfma_f32_32x32x16_bf16(pa0,PK(0),o[d0],0,0,0);
    o[d0]=__builtin_amdgcn_mfma_f32_32x32x16_bf16(pa1,PK(1),o[d0],0,0,0);
    o[d0]=__builtin_amdgcn_mfma_f32_32x32x16_bf16(pa2,PK(2),o[d0],0,0,0);
    o[d0]=__builtin_amdgcn_mfma_f32_32x32x16_bf16(pa3,PK(3),o[d0],0,0,0);
    #undef PK
  }
}

template<int THRL> __device__ __forceinline__ void fox_unit(const int b,const int qb,const bf16_t*qT,const bf16_t*__restrict__ kT,const bf16_t*__restrict__ vT,bf16_t*Oh,LAS unsigned char*shm,const LAS float*biasf){
  const int tid=fresh_tid(),lane=tid&63,r32=lane&31,hi=lane>>5; const int wid=__builtin_amdgcn_readfirstlane(tid>>6);
  const size_t tok0=(size_t)b*SEQ; const int q0=qb*QB;
  const bf16_t*qsrc=qT+(tok0+q0+wid*QBLK+r32)*32+8*hi;
  const unsigned lds0=(unsigned)(uintptr_t)shm;
  LAS float*wsf=(LAS float*)(shm+LDS_WS)+wid*64;
  const bf16_t*ksrc=kT+(tok0+lane+(size_t)(wid>>2)*SEQ)*32+(wid&3)*8;
  const bf16_t*vsrc=vT+(tok0+16*(wid&3)+(lane>>2)+(size_t)(wid>>2)*SEQ)*32+(lane&3)*8;
  const unsigned kdst=lds0+LDS_K+wid*1024, vdst=lds0+LDS_V+wid*1024;
  #define DMA_K(t,slot) glds16(ksrc+(size_t)(t)*KVBLK*32,(unsigned)__builtin_amdgcn_readfirstlane(kdst+(slot)))
  #define DMA_V(t,slot) glds16(vsrc+(size_t)(t)*KVBLK*32,(unsigned)__builtin_amdgcn_readfirstlane(vdst+(slot)))
  const int vb0=(int)(lds0+LDS_V)+((lane>>4)&1)*32+(lane&3)*8+(4*hi+((lane&15)>>2))*64;
  bf16x8 kf[8];
  const lds_cptr shm3=(lds_cptr)shm; const lds_cptr Kbase=shm3+LDS_K; const lds_cptr kp0=shm3+LDS_K+hi*1024+r32*16; const lds_cptr vp0=shm3+LDS_V+((lane>>4)&1)*32+(lane&3)*8+(4*hi+((lane&15)>>2))*64;
  const int NT=(q0+QB)/KVBLK;
  DMA_K(0,0);DMA_V(0,0);DMA_K(1,SLOTB);
  bf16x8 qr[4];
  #pragma unroll
  for(int d0=0;d0<4;++d0)qr[d0]=*reinterpret_cast<const bf16x8*>(qsrc+(size_t)(d0>>1)*SEQ*32+16*(d0&1));
  float mhat=0.f,l_reg=0.f;f32x16 o[2];o[0]=f32x16{};o[1]=f32x16{};
  const int qrel=wid*QBLK+r32;
  #define CMASK(P0,P1,t) do{int jb_=(t)-(NT-4); if(jb_>=0)cmask(P0,P1,jb_,qrel,hi);}while(0)
  bool resc=false;
    \
  #define START(P0,P1) do{ const float rm=rowmax(P0,P1); resc=false; mhat=__builtin_fmaxf(biasf[q0+qrel]-20.0f, rm-(float)THRL); \
    _Pragma("unroll") for(int r=0;r<16;++r)P0[r]=__builtin_amdgcn_exp2f(P0[r]-mhat); }while(0)
  #define RESC() do{ if(resc){ asm volatile("s_waitcnt lgkmcnt(0)":::"memory"); \
      _Pragma("unroll") for(int d_=0;d_<2;++d_) _Pragma("unroll") for(int r=0;r<16;++r)o[d_][r]*=wsf[crow(r,hi)]; } }while(0)
  f32x16 pA0,pA1,pB0,pB1;
  int sl_prev=0,sl_cur=0,sl_next=SLOTB;
  #define ROT() do{sl_prev=sl_cur;sl_cur=sl_next;sl_next=(sl_next==(NSLOT-1)*SLOTB)?0:sl_next+SLOTB;}while(0)
  DMA_K(2,2*SLOTB);
  WAIT_BAR(3);
  { const LAS float*bp0_=biasf+4*hi; _Pragma("unroll") for(int g=0;g<4;++g){ const f32x4 x0_=*(const LAS f32x4*)(bp0_+8*g), x1_=*(const LAS f32x4*)(bp0_+32+8*g); _Pragma("unroll") for(int j=0;j<4;++j){pA0[4*g+j]=x0_[j];pA1[4*g+j]=x1_[j];} } }
  qkt(pA0,pA1,Kbase,qr,r32,hi);asm volatile("s_nop 15\n\ts_nop 7":"+v"(pA0),"+v"(pA1));CMASK(pA0,pA1,0);
  START(pA0,pA1);
  _Pragma("unroll") for(int r=0;r<16;++r)pA1[r]=__builtin_amdgcn_exp2f(pA1[r]-mhat);
  WAIT_BAR(0);
  DMA_K(3,0);DMA_V(1,SLOTB);
  ROT();
  kload8(kf,kp0+sl_cur);
  { const LAS float*bp1_=biasf+KVBLK+4*hi; _Pragma("unroll") for(int g=0;g<4;++g){ const f32x4 x0_=*(const LAS f32x4*)(bp1_+8*g), x1_=*(const LAS f32x4*)(bp1_+32+8*g); _Pragma("unroll") for(int j=0;j<4;++j){pB0[4*g+j]=x0_[j];pB1[4*g+j]=x1_[j];} } }
  WAIT_BAR(2);
  s16x4 vlo[8],vhi[8]; u32x4 pw0,pw1,pw2,pw3;
  #define PKW(P,B) cvtpk_s(P[B],P[B+1])
  #define PAF(k) __builtin_bit_cast(bf16x8,pw##k)
  #define VFR(i) (bf16x8){vlo[i][0],vlo[i][1],vlo[i][2],vlo[i][3],vhi[i][0],vhi[i][1],vhi[i][2],vhi[i][3]}
  #define PIN(x) asm volatile("":"+v"(x))
  #define MX3(a,b,c) __builtin_fmaxf(__builtin_fmaxf((a),(b)),(c))
  #define GAPA(MF,A0,A1,A2,A3,W0,W1,PW) do{ MF; sacc+=A0; sacc+=A1; sacc+=A2; sacc+=A3; PIN(sacc); W0; W1; PIN(PW); SBAR(); }while(0)
  #define EX(v) __builtin_amdgcn_exp2f(v)
  #define GAPB(MF,X,B) do{ MF; X[B]=EX(X[B]-mhat); X[B+1]=EX(X[B+1]-mhat); X[B+2]=EX(X[B+2]-mhat); X[B+3]=EX(X[B+3]-mhat); PIN(X); SBAR(); }while(0)
  #define VRD(i) do{ vlo[i]=vtr(vp_+(((i)>>2)*4096+((i)&3)*1024)); vhi[i]=vtr(vp_+(((i)>>2)*4096+((i)&3)*1024+512)); }while(0)
  #define KRD(G,j) do{ if(G){ kload2(kf,kp0+sl_next,j); SBAR(); } }while(0)
  #define BRD1(P,O_,g) do{ const f32x4 x_=*(const LAS f32x4*)(bp_+(O_)+8*(g)); P[4*(g)]=x_[0];P[4*(g)+1]=x_[1];P[4*(g)+2]=x_[2];P[4*(g)+3]=x_[3]; }while(0)
  #define BRD(G,P,O_,g) do{ if(G){ BRD1(P,O_,g); BRD1(P,O_,(g)+1); SBAR(); } }while(0)
  #define STEP(C0,C1,P0,P1,t,GK,GV,GL) do{ SBAR(); \
    const lds_cptr vp_=vp0+sl_prev; \
    VRD(0); SBAR(); float sacc=(P0[0]+P0[1]); \
    GAPA(C0=__builtin_amdgcn_mfma_f32_32x32x16_bf16(kf[0],qr[0],C0,0,0,0), P0[2],P0[3],P0[4],P0[5],     pw0[0]=PKW(P0,0), pw0[1]=PKW(P0,2), pw0); \
    VRD(4); SBAR(); GAPA(C1=__builtin_amdgcn_mfma_f32_32x32x16_bf16(kf[1],qr[0],C1,0,0,0), P0[6],P0[7],P0[8],P0[9],     pw0[2]=PKW(P0,4), pw0[3]=PKW(P0,6), pw0); \
    VRD(1); SBAR(); GAPA(C0=__builtin_amdgcn_mfma_f32_32x32x16_bf16(kf[2],qr[1],C0,0,0,0),   P0[10],P0[11],P0[12],P0[13], pw1[0]=PKW(P0,8), pw1[1]=PKW(P0,10), pw1); \
    VRD(5); SBAR(); GAPA(C1=__builtin_amdgcn_mfma_f32_32x32x16_bf16(kf[3],qr[1],C1,0,0,0),   P0[14],P0[15],P1[0],P1[1],   pw1[2]=PKW(P0,12),pw1[3]=PKW(P0,14), pw1); \
    VRD(2); SBAR(); GAPA(C0=__builtin_amdgcn_mfma_f32_32x32x16_bf16(kf[4],qr[2],C0,0,0,0),   P1[2],P1[3],P1[4],P1[5],     pw2[0]=PKW(P1,0), pw2[1]=PKW(P1,2), pw2); \
    VRD(6); SBAR(); GAPA(C1=__builtin_amdgcn_mfma_f32_32x32x16_bf16(kf[5],qr[2],C1,0,0,0),   P1[6],P1[7],P1[8],P1[9],     pw2[2]=PKW(P1,4), pw2[3]=PKW(P1,6), pw2); \
    VRD(3); SBAR(); GAPA(C0=__builtin_amdgcn_mfma_f32_32x32x16_bf16(kf[6],qr[3],C0,0,0,0),   P1[10],P1[11],P1[12],P1[13], pw3[0]=PKW(P1,8), pw3[1]=PKW(P1,10), pw3); \
    VRD(7); SBAR(); GAPA(C1=__builtin_amdgcn_mfma_f32_32x32x16_bf16(kf[7],qr[3],C1,0,0,0),   P1[14],P1[15],0.f,0.f,       pw3[2]=PKW(P1,12),pw3[3]=PKW(P1,14), pw3); \
    l_reg+=sacc; \
    if(GK){DMA_K((t)+3,sl_cur);} if(GV){DMA_V((t)+1,sl_next);} \
    CMASK(C0,C1,t); \
    { float a=MX3(C0[0],C0[1],C1[0]),b=MX3(C0[2],C0[3],C1[1]); a=MX3(a,C1[2],C1[3]); \
      _Pragma("unroll") for(int r=4;r<16;r+=4){a=MX3(a,C0[r],C0[r+1]);b=MX3(b,C0[r+2],C0[r+3]);a=MX3(a,C1[r],C1[r+1]);b=MX3(b,C1[r+2],C1[r+3]);} \
      float rm=__builtin_fmaxf(a,b); { auto rr=__builtin_amdgcn_permlane32_swap(__float_as_uint(rm),__float_as_uint(rm),false,false); rm=__builtin_fmaxf(__uint_as_float(rr[0]),__uint_as_float(rr[1])); } \
      resc=false; \
      if(__builtin_expect(__builtin_amdgcn_ballot_w64(rm-mhat>(float)THRL)!=0ull,0)){ const float dl=__builtin_fmaxf(rm-mhat,0.f); mhat+=dl; \
        const float f=__builtin_amdgcn_exp2f(-dl); l_reg*=f; if(hi==0)wsf[r32]=f; resc=true; } } \
    SBAR(); \
    const LAS float*bp_=biasf+((t)+1)*KVBLK+4*hi; \
    BRD(GL,P0,0,0); GAPB(o[0]=__builtin_amdgcn_mfma_f32_32x32x16_bf16(PAF(0),VFR(0),o[0],0,0,0), C0,0); \
    BRD(GL,P0,0,2); GAPB(o[1]=__builtin_amdgcn_mfma_f32_32x32x16_bf16(PAF(0),VFR(4),o[1],0,0,0), C0,4); \
    KRD(GL,0); GAPB(o[0]=__builtin_amdgcn_mfma_f32_32x32x16_bf16(PAF(1),VFR(1),o[0],0,0,0), C0,8); \
    KRD(GL,1); GAPB(o[1]=__builtin_amdgcn_mfma_f32_32x32x16_bf16(PAF(1),VFR(5),o[1],0,0,0), C0,12); \
    KRD(GL,2); GAPB(o[0]=__builtin_amdgcn_mfma_f32_32x32x16_bf16(PAF(2),VFR(2),o[0],0,0,0), C1,0); \
    KRD(GL,3); GAPB(o[1]=__builtin_amdgcn_mfma_f32_32x32x16_bf16(PAF(2),VFR(6),o[1],0,0,0), C1,4); \
    BRD(GL,P1,32,0); GAPB(o[0]=__builtin_amdgcn_mfma_f32_32x32x16_bf16(PAF(3),VFR(3),o[0],0,0,0), C1,8); \
    BRD(GL,P1,32,2); GAPB(o[1]=__builtin_amdgcn_mfma_f32_32x32x16_bf16(PAF(3),VFR(7),o[1],0,0,0), C1,12); \
    }while(0)
  int t=1;
  #undef CMASK
  #define CMASK(P0,P1,t) do{}while(0)
  for(;t+5<NT;t+=2){
    STEP(pB0,pB1,pA0,pA1,t,true,true,true);     WAIT_BAR(2); RESC(); ROT();
    STEP(pA0,pA1,pB0,pB1,t+1,true,true,true);   WAIT_BAR(2); RESC(); ROT();
  }
  #undef CMASK
  #define CMASK(P0,P1,t) do{int jb_=(t)-(NT-4); if(jb_>=0)cmask(P0,P1,jb_,qrel,hi);}while(0)
  #define ENDW(tt) do{ if((tt)+3<NT){WAIT_BAR(2);} else if((tt)+2<NT){WAIT_BAR(1);} else {WAIT_BAR(0);} }while(0)
  for(;t+1<NT;t+=2){
    STEP(pB0,pB1,pA0,pA1,t,(t+3<NT),(t+1<NT),(t+1<NT));       ENDW(t);   RESC(); ROT();
    STEP(pA0,pA1,pB0,pB1,t+1,(t+4<NT),(t+2<NT),(t+2<NT));     ENDW(t+1); RESC(); ROT();
  }
  STEP(pB0,pB1,pA0,pA1,NT-1,false,false,false); RESC();
  { float sacc=pB0[0]+pB0[1]; _Pragma("unroll") for(int r=2;r<16;++r)sacc+=pB0[r]; _Pragma("unroll") for(int r=0;r<16;++r)sacc+=pB1[r]; l_reg+=sacc;
    pw0=(u32x4){PKW(pB0,0),PKW(pB0,2),PKW(pB0,4),PKW(pB0,6)};pw1=(u32x4){PKW(pB0,8),PKW(pB0,10),PKW(pB0,12),PKW(pB0,14)};pw2=(u32x4){PKW(pB1,0),PKW(pB1,2),PKW(pB1,4),PKW(pB1,6)};pw3=(u32x4){PKW(pB1,8),PKW(pB1,10),PKW(pB1,12),PKW(pB1,14)};
    SBAR(); pv(o,vb0+sl_cur,PAF(0),PAF(1),PAF(2),PAF(3)); }
  #undef PKW
  #undef PAF
  #undef VFR
  #undef PIN
  #undef MX3
  #undef GAPA
  #undef GAPB
  #undef EX
  #undef VRD
  #undef KRD
  #undef BRD
  #undef BRD1
  #undef STEP
  #undef ENDW
  {auto rr=__builtin_amdgcn_permlane32_swap(__float_as_uint(l_reg),__float_as_uint(l_reg),false,false);l_reg=__uint_as_float(rr[0])+__uint_as_float(rr[1]);}
  if(hi==0)wsf[32+r32]=l_reg;asm volatile("s_waitcnt lgkmcnt(0)":::"memory");
  float rli[16];
  #pragma unroll
  for(int r=0;r<16;++r)rli[r]=__builtin_amdgcn_rcpf(wsf[32+crow(r,hi)]);
  bf16_t*Ow=Oh+(tok0+q0+wid*QBLK)*(size_t)1024;
  { LAS bf16_t*stg=(LAS bf16_t*)(shm+LDS_OST)+wid*2048;
    #pragma unroll
    for(int r=0;r<16;++r){const int orow=crow(r,hi);
      #pragma unroll
      for(int d0=0;d0<2;++d0)stg[orow*64+d0*32+r32]=(bf16_t)cvt_pk_bf16(o[d0][r]*rli[r],0.f);}
    asm volatile("s_waitcnt lgkmcnt(0)":::"memory");
    #pragma unroll
    for(int i=0;i<4;++i){const int row=i*8+(lane>>3),ch=lane&7; const u32x4 v=*(const LAS u32x4*)(stg+row*64+ch*8); *(u32x4*)(Ow+(size_t)row*1024+ch*8)=v;} }
  asm volatile("s_waitcnt lgkmcnt(0)\n\ts_barrier":::"memory");
  #undef DMA_K
  #undef DMA_V
  #undef CMASK
  #undef START
  #undef RESC
  #undef ROT
}
#undef SBAR
#undef WAIT_BAR
}
static_assert(fx::LDS_BYTES <= BIAS_OFF, "forgetting-attention LDS map");
}

struct Args {
    const float *x, *c, *w_ada, *b_ada, *w_in, *b_forget, *b_gate, *w_br_fox, *w_br_dil, *w_o, *ln_g, *ln_b, *w_router, *router_bias,
                *w_eg, *w_eu, *w_ed, *w_sg, *w_su, *w_sd;
    float* out; unsigned char* ws;
    int g0, g1, sync, pad;
};
typedef const __attribute__((address_space(4))) Args CArgs;
#define KARGS() ({ CArgs* p_ = (CArgs*)__builtin_amdgcn_kernarg_segment_ptr(); asm volatile("" : "+s"(p_)); p_; })

DI int rc(int lane) { return (lane >> 4) * 256 + ((lane >> 2) & 3) * 32 + (lane & 3) * 8; }
DI void row_load_f32(const float* p, int lane, float (&v)[16]) {
#pragma unroll
    for (int j = 0; j < 2; ++j) { const f32x4 a = *(const f32x4*)(p + rc(lane) + 128 * j), b = *(const f32x4*)(p + rc(lane) + 128 * j + 4);
#pragma unroll
        for (int i = 0; i < 4; ++i) { v[j * 8 + i] = a[i]; v[j * 8 + 4 + i] = b[i]; } }
}
DI void row_store_f32(float* p, int lane, const float (&v)[16]) {
#pragma unroll
    for (int j = 0; j < 2; ++j) { *(f32x4*)(p + rc(lane) + 128 * j) = (f32x4){v[j * 8], v[j * 8 + 1], v[j * 8 + 2], v[j * 8 + 3]}; *(f32x4*)(p + rc(lane) + 128 * j + 4) = (f32x4){v[j * 8 + 4], v[j * 8 + 5], v[j * 8 + 6], v[j * 8 + 7]}; }
}
DI void row_store_bf16(bf16_t* p, int lane, const float (&v)[16]) {
#pragma unroll
    for (int j = 0; j < 2; ++j) { u32x4 w; w.x = cvt_pk_bf16(v[j * 8], v[j * 8 + 1]); w.y = cvt_pk_bf16(v[j * 8 + 2], v[j * 8 + 3]); w.z = cvt_pk_bf16(v[j * 8 + 4], v[j * 8 + 5]); w.w = cvt_pk_bf16(v[j * 8 + 6], v[j * 8 + 7]);
        *(u32x4*)(p + rc(lane) + 128 * j) = w; }
}
DI void row_load_bf16(const bf16_t* p, int lane, float (&v)[16]) {
#pragma unroll
    for (int j = 0; j < 2; ++j) { const u32x4 w = *(const u32x4*)(p + rc(lane) + 128 * j);
        v[j * 8 + 0] = bf_lo(w.x); v[j * 8 + 1] = bf_hi(w.x); v[j * 8 + 2] = bf_lo(w.y); v[j * 8 + 3] = bf_hi(w.y); v[j * 8 + 4] = bf_lo(w.z); v[j * 8 + 5] = bf_hi(w.z); v[j * 8 + 6] = bf_lo(w.w); v[j * 8 + 7] = bf_hi(w.w); }
}
DI void row_load_f32_nt(const float* p, int lane, float (&v)[16]) {
#pragma unroll
    for (int j = 0; j < 2; ++j) { const f32x4 a = __builtin_nontemporal_load((const f32x4*)(p + rc(lane) + 128 * j)), b = __builtin_nontemporal_load((const f32x4*)(p + rc(lane) + 128 * j + 4));
#pragma unroll
        for (int i = 0; i < 4; ++i) { v[j * 8 + i] = a[i]; v[j * 8 + 4 + i] = b[i]; } }
}
DI void row_store_f32_nt(float* p, int lane, const float (&v)[16]) {
#pragma unroll
    for (int j = 0; j < 2; ++j) { __builtin_nontemporal_store((f32x4){v[j * 8], v[j * 8 + 1], v[j * 8 + 2], v[j * 8 + 3]}, (f32x4*)(p + rc(lane) + 128 * j)); __builtin_nontemporal_store((f32x4){v[j * 8 + 4], v[j * 8 + 5], v[j * 8 + 6], v[j * 8 + 7]}, (f32x4*)(p + rc(lane) + 128 * j + 4)); }
}
DI void row_load_bf16_nt(const bf16_t* p, int lane, float (&v)[16]) {
#pragma unroll
    for (int j = 0; j < 2; ++j) { const u32x4 w = __builtin_nontemporal_load((const u32x4*)(p + rc(lane) + 128 * j));
        v[j * 8 + 0] = bf_lo(w.x); v[j * 8 + 1] = bf_hi(w.x); v[j * 8 + 2] = bf_lo(w.y); v[j * 8 + 3] = bf_hi(w.y); v[j * 8 + 4] = bf_lo(w.z); v[j * 8 + 5] = bf_hi(w.z); v[j * 8 + 6] = bf_lo(w.w); v[j * 8 + 7] = bf_hi(w.w); }
}
DI void row_layernorm(float (&v)[16], const float (&g)[16], const float (&bb)[16]) {
    float s = 0.f;
#pragma unroll
    for (int i = 0; i < 16; ++i) s += v[i];
    const float mean = wave_sum(s) * (1.0f / D);
    float q = 0.f;
#pragma unroll
    for (int i = 0; i < 16; ++i) { v[i] -= mean; q += v[i] * v[i]; }
    const float rstd = rsqrtf(wave_sum(q) * (1.0f / D) + LN_EPS);
#pragma unroll
    for (int i = 0; i < 16; ++i) v[i] = v[i] * rstd * g[i] + bb[i];
}
DI void emit_u_logf(const float (&xv)[16], const float* modl, const LAS float* wff, const float* bforget, bf16_t* urow, float* lfrow, int lane_in) {
    int lane = lane_in; asm volatile("" : "+v"(lane));
    float sh[16], sc[16], uf[16];
    row_load_f32(modl, lane, sh); row_load_f32(modl + 1024, lane, sc);
#pragma unroll
    for (int i = 0; i < 16; ++i) uf[i] = xv[i] * (1.0f + sc[i]) + sh[i];
    row_store_bf16(urow, lane, uf);
    float p[8];
#pragma unroll
    for (int hd = 0; hd < 8; ++hd) p[hd] = 0.f;
#pragma unroll
    for (int j = 0; j < 2; ++j)
#pragma unroll
        for (int i = 0; i < 8; ++i) { const int k = rc(lane) + 128 * j + i; const f32x4 w0 = *(const LAS f32x4*)(wff + k * 8), w1 = *(const LAS f32x4*)(wff + k * 8 + 4);
            const float u = uf[j * 8 + i];
            p[0] += u * w0[0]; p[1] += u * w0[1]; p[2] += u * w0[2]; p[3] += u * w0[3]; p[4] += u * w1[0]; p[5] += u * w1[1]; p[6] += u * w1[2]; p[7] += u * w1[3]; }
    const bool b5 = (lane & 32) != 0, b4 = (lane & 16) != 0, b3 = (lane & 8) != 0;
    float a4[4], a2[2];
#pragma unroll
    for (int j = 0; j < 4; ++j) { const float keep = b5 ? p[4 + j] : p[j], send = b5 ? p[j] : p[4 + j]; a4[j] = keep + __shfl_xor(send, 32); }
#pragma unroll
    for (int j = 0; j < 2; ++j) { const float keep = b4 ? a4[2 + j] : a4[j], send = b4 ? a4[j] : a4[2 + j]; a2[j] = keep + __shfl_xor(send, 16); }
    float mine;
    { const float keep = b3 ? a2[1] : a2[0], send = b3 ? a2[0] : a2[1]; mine = keep + __shfl_xor(send, 8); }
    mine += __shfl_xor(mine, 4); mine += __shfl_xor(mine, 2); mine += __shfl_xor(mine, 1);
    if ((lane & 7) == 0) { const int hd = lane >> 3; const float xx = mine + bforget[hd]; lfrow[hd] = fminf(xx, 0.f) - 0.6931471805599453f * __builtin_amdgcn_logf(1.0f + __builtin_amdgcn_exp2f(-fabsf(xx) * LOG2E)); }
}
DI void load_wff(const float* w_in_l, LAS float* wff) {
    for (int idx = fresh_tid(); idx < 1024 * 8; idx += 512) wff[idx] = w_in_l[(size_t)(idx >> 3) * INCOLS + 1536 + (idx & 7)];
}

DI void phase_pre(CArgs& a, LAS unsigned char* ring) {
    float* mod = (float*)(a.ws + WS_MOD); float* cosT = (float*)(a.ws + WS_ROPE); float* sinT = cosT + 2048 * 32;
    LAS float* cs = (LAS float*)ring;
    const int tid = fresh_tid();
    for (int unit = blockIdx.x; unit < 192 + 64; unit += gridDim.x) {
        if (unit < 192) {
            const int l = unit / 48, cb = unit % 48;
            __syncthreads();
#pragma unroll 4
            for (int idx = tid; idx < 32768; idx += 512) { const int k = idx >> 5, j = idx & 31; const float cv = a.c[j * D + k]; cs[idx] = cv * fast_sigmoid(cv); }
            __syncthreads();
            const int col = tid & 127, kq = tid >> 7, n = cb * 128 + col;
            float acc[32];
#pragma unroll
            for (int j = 0; j < 32; ++j) acc[j] = 0.f;
            const float* wp = a.w_ada + (size_t)l * D * 6144 + (size_t)(kq * 256) * 6144 + n;
            const LAS float* cq = cs + kq * 256 * 32;
#pragma unroll 8
            for (int k = 0; k < 256; ++k) { const float w = __builtin_nontemporal_load(wp + (size_t)k * 6144);
#pragma unroll
                for (int g = 0; g < 8; ++g) { const f32x4 c4 = *(const LAS f32x4*)(cq + k * 32 + 4 * g);
                    acc[4 * g] += w * c4[0]; acc[4 * g + 1] += w * c4[1]; acc[4 * g + 2] += w * c4[2]; acc[4 * g + 3] += w * c4[3]; } }
            __syncthreads();
#pragma unroll
            for (int j = 0; j < 32; ++j) cs[(kq * 32 + j) * 128 + col] = acc[j];
            __syncthreads();
            const float bb = a.b_ada[l * 6144 + n];
#pragma unroll
            for (int jj = 0; jj < 8; ++jj) { const int j = kq * 8 + jj;
                const float v = cs[(0 * 32 + j) * 128 + col] + cs[(1 * 32 + j) * 128 + col] + cs[(2 * 32 + j) * 128 + col] + cs[(3 * 32 + j) * 128 + col];
                mod[(size_t)(l * 32 + j) * 6144 + n] = v + bb; }
        } else {
#pragma unroll 1
            for (int half = 0; half < 2; ++half) {
                const int idx = ((unit - 192) * 2 + half) * 512 + tid;
                const int pos = idx >> 5, i = idx & 31;
                const float invf = powf(10000.0f, -(float)i * (2.0f / 64.0f));
                const float ang = (float)pos * invf;
                cosT[idx] = cosf(ang); sinT[idx] = sinf(ang); }
        }
    }
    __syncthreads();
}

DI void phase_w(CArgs& a, LAS unsigned char* ring, const int l) {
    LAS float* tile = (LAS float*)ring;
    LAS float* wff = (LAS float*)(ring + 69632);
    unsigned char* W = a.ws + WS_W;
    const int tid = fresh_tid();
    for (int t = blockIdx.x; t < 3584; t += gridDim.x) {
        const float* src; int ld, K, n0, k0, kd = 0; bf16_t* dst; int kind; int e = 0;
        if (t < 320) { kind = 0; src = a.w_in + (size_t)l * D * INCOLS; ld = INCOLS; K = D; n0 = (t % 80) * 64; k0 = (t / 80) * 256; dst = (bf16_t*)(W + W_IN); }
        else if (t < 352) { const int q = t - 320; kind = 1; src = a.w_br_fox + (size_t)l * 512 * D; ld = D; K = D; n0 = (q / 2) * 64; k0 = (q % 2) * 256; dst = (bf16_t*)(W + W_BF); }
        else if (t < 384) { const int q = t - 352; kind = 1; src = a.w_br_dil + (size_t)l * 512 * D; ld = D; K = D; kd = 512; n0 = (q / 2) * 64; k0 = (q % 2) * 256; dst = (bf16_t*)(W + W_BF); }
        else if (t < 448) { const int q = t - 384; kind = 1; src = a.w_o + (size_t)l * D * D; ld = D; K = D; n0 = (q % 16) * 64; k0 = (q / 16) * 256; dst = (bf16_t*)(W + W_O); }
        else if (t < 464) { const int q = t - 448; kind = 2; src = a.w_router + (size_t)l * D * NE; ld = NE; K = D; n0 = (q / 4) * 64; k0 = (q % 4) * 256; dst = (bf16_t*)(W + W_R); }
        else if (t < 464 + 2080) { const int q = t - 464; e = q / 32; const int qq = q % 32; kind = 3; ld = 256; K = D; n0 = (qq % 8) * 64; k0 = (qq / 8) * 256; dst = (bf16_t*)(W + W_GU) + (size_t)e * 512 * D;
            const int isup = (n0 >> 7) & 1;
            src = (e < NE) ? ((isup ? a.w_eu : a.w_eg) + (size_t)(l * NE + e) * D * 256) : ((isup ? a.w_su : a.w_sg) + (size_t)l * D * 256); }
        else { const int q = t - 464 - 2080; e = q / 16; const int qq = q % 16; kind = 1; ld = D; K = 256; n0 = qq * 64; k0 = 0; dst = (bf16_t*)(W + W_DN) + (size_t)e * D * 256;
            src = (e < NE) ? (a.w_ed + (size_t)(l * NE + e) * 256 * D) : (a.w_sd + (size_t)l * 256 * D); }
        const int nl = (tid & 15) * 4; const int j = n0 + nl; int scol = j; bool valid = true;
        if (kind == 0) {
            if (j < 1536) scol = j;
            else if (j < 2560) { const int cc = j - 1536, hd = cc >> 6, p = cc & 63, g = p >> 3, jj = p & 7; const int d = (jj < 4) ? (4 * g + jj) : (32 + 4 * g + (jj - 4)); scol = 1544 + hd * 64 + d; }
            else scol = j + 8;
        } else if (kind == 2) { valid = (j < NE); scol = valid ? j : 0; }
        else if (kind == 3) { const int pnn = j >> 8, w = j & 255; scol = 128 * pnn + (w & 127); }
        __syncthreads();
        { const float* sp = src + (size_t)(k0 + (tid >> 4)) * ld + scol;
#pragma unroll
          for (int i = 0; i < 8; ++i) { const int k = (tid >> 4) + 32 * i; const f32x4 v = valid ? __builtin_nontemporal_load((const f32x4*)(sp + (size_t)(32 * i) * ld)) : (f32x4){0.f, 0.f, 0.f, 0.f};
              tile[k * 65 + nl] = v[0]; tile[k * 65 + nl + 1] = v[1]; tile[k * 65 + nl + 2] = v[2]; tile[k * 65 + nl + 3] = v[3]; } }
        __syncthreads();
        { const int n2 = tid >> 3;
#pragma unroll
          for (int c4 = 0; c4 < 4; ++c4) { const int ks = (tid & 7) * 8 + 64 * c4; float v[8];
#pragma unroll
            for (int i = 0; i < 8; ++i) v[i] = tile[(ks + i) * 65 + n2];
            u32x4 w; w.x = cvt_pk_bf16(v[0], v[1]); w.y = cvt_pk_bf16(v[2], v[3]); w.z = cvt_pk_bf16(v[4], v[5]); w.w = cvt_pk_bf16(v[6], v[7]);
            __builtin_nontemporal_store(w, (u32x4*)(dst + (size_t)(n0 + n2) * K + kd + k0 + ks)); } }
    }
    if (l == 0) {
        __syncthreads();
        load_wff(a.w_in, wff);
        __syncthreads();
        const int wid = tid >> 6, lane = tid & 63;
        const float* mod = (const float*)(a.ws + WS_MOD);
        bf16_t* U = (bf16_t*)(a.ws + WS_U); float* LF = (float*)(a.ws + WS_LOGF);
        for (int row = blockIdx.x * 8 + wid; row < NTOK; row += gridDim.x * 8) {
            float xv[16]; row_load_f32_nt(a.x + (size_t)row * D, lane, xv);
            emit_u_logf(xv, mod + (size_t)(0 * 32 + (row >> 11)) * 6144, wff, a.b_forget, U + (size_t)row * D, LF + (size_t)row * 8, lane);
        }
    }
    __syncthreads();
}

DI void phase_ln1(CArgs& a, const int l, const bool dry) {
    const int tid = fresh_tid(), wid = tid >> 6, lane = tid & 63;
    const float* mod = (const float*)(a.ws + WS_MOD); bf16_t* U = (bf16_t*)(a.ws + WS_U); bf16_t* XB = (bf16_t*)(a.ws + WS_XB);
    float g[16], bb[16];
    row_load_f32(a.ln_g + (size_t)(l * 2 + 0) * D, lane, g); row_load_f32(a.ln_b + (size_t)(l * 2 + 0) * D, lane, bb);
    for (int row = blockIdx.x * 8 + wid; row < NTOK / 2; row += gridDim.x * 8) {
        float v[16], w[16]; row_load_bf16_nt(XB + (size_t)row * D, lane, v); row_load_bf16_nt(XB + (size_t)(row + NTOK / 2) * D, lane, w);
        {   const float* modl = mod + (size_t)(l * 32 + (row >> 11)) * 6144;
            float sh[16], sc[16]; row_load_f32(modl + 3072, lane, sh); row_load_f32(modl + 4096, lane, sc);
            row_layernorm(v, g, bb);
            row_store_bf16(XB + (size_t)row * D, lane, v);
#pragma unroll
            for (int i = 0; i < 16; ++i) v[i] = v[i] * (1.0f + sc[i]) + sh[i];
            row_store_bf16(U + (size_t)row * D, lane, v); }
        {   const int r2 = row + NTOK / 2;
            const float* modl = mod + (size_t)(l * 32 + (r2 >> 11)) * 6144;
            float sh[16], sc[16]; row_load_f32(modl + 3072, lane, sh); row_load_f32(modl + 4096, lane, sc);
            row_layernorm(w, g, bb);
            row_store_bf16(XB + (size_t)r2 * D, lane, w);
#pragma unroll
            for (int i = 0; i < 16; ++i) w[i] = w[i] * (1.0f + sc[i]) + sh[i];
            row_store_bf16(U + (size_t)r2 * D, lane, w); }
    }
}

DI void phase_route(CArgs& a, LAS unsigned char* lds, const int l, const bool dry) {
    LAS float* Ssc = (LAS float*)(lds + RING_OFF);
    LAS float* rb = (LAS float*)(lds + LM_RB);
    LAS int* lh = (LAS int*)(lds + LM_LH);
    const float* LG = (const float*)(a.ws + WS_LOGITS);
    int* EIDX = (int*)(a.ws + WS_EIDX); float* GW = (float*)(a.ws + WS_GW);
    unsigned* CNT = (unsigned*)(a.ws + WS_CTL) + CW_CNT + (dry ? 2048 : 0);
    const int tid = fresh_tid();
    if (tid < NE) rb[tid] = a.router_bias[l * NE + tid];
    for (int tb = blockIdx.x; tb < NTOK / 256; tb += gridDim.x) {
        __syncthreads();
        if (tid < 80) lh[tid] = 0;
#pragma unroll 4
        for (int i = 0; i < 32; ++i) { const int idx = tid + 512 * i; const int tk = idx >> 6, e = idx & 63; Ssc[tk * 65 + e] = fast_sigmoid(__builtin_nontemporal_load(LG + (size_t)tb * 256 * 64 + idx)); }
        __syncthreads();
        if (tid < 256) {
            const LAS float* S = Ssc + tid * 65;
            float gs[8];
#pragma unroll
            for (int g = 0; g < 8; ++g) { float m1 = -3.0e38f, m2 = -3.0e38f;
#pragma unroll
                for (int j = 0; j < 8; ++j) { const float v = S[8 * g + j] + rb[8 * g + j]; if (v > m1) { m2 = m1; m1 = v; } else if (v > m2) m2 = v; }
                gs[g] = m1 + m2; }
            unsigned gmask = 0;
#pragma unroll
            for (int g = 0; g < 8; ++g) { int rank = 0;
#pragma unroll
                for (int g2 = 0; g2 < 8; ++g2) rank += ((gs[g2] > gs[g]) || (gs[g2] == gs[g] && g2 < g)) ? 1 : 0;
                gmask |= (rank < 4) ? (1u << g) : 0u; }
            float vv[64];
#pragma unroll
            for (int e = 0; e < NE; ++e) vv[e] = ((gmask >> (e >> 3)) & 1u) ? (S[e] + rb[e]) : -3.0e38f;
            int idx[8]; float sc[8]; float ssum = 0.f;
#pragma unroll
            for (int k = 0; k < 8; ++k) {
                float mxv = vv[0];
#pragma unroll
                for (int e = 1; e < NE; ++e) mxv = fmaxf(mxv, vv[e]);
                int bi = 0;
#pragma unroll
                for (int e = NE - 1; e >= 0; --e) bi = (vv[e] == mxv) ? e : bi;
#pragma unroll
                for (int e = 0; e < NE; ++e) vv[e] = (e == bi) ? -3.0e38f : vv[e];
                idx[k] = bi; sc[k] = S[bi]; ssum += sc[k]; }
            const float rs = 2.5f / ssum;
            const size_t tok = (size_t)tb * 256 + tid;
            *(i32x4*)(EIDX + tok * 8) = (i32x4){idx[0], idx[1], idx[2], idx[3]}; *(i32x4*)(EIDX + tok * 8 + 4) = (i32x4){idx[4], idx[5], idx[6], idx[7]};
            *(f32x4*)(GW + tok * 8) = (f32x4){sc[0] * rs, sc[1] * rs, sc[2] * rs, sc[3] * rs}; *(f32x4*)(GW + tok * 8 + 4) = (f32x4){sc[4] * rs, sc[5] * rs, sc[6] * rs, sc[7] * rs};
#pragma unroll
            for (int k = 0; k < 8; ++k) atomicAdd((int*)&lh[idx[k]], 1);
        }
        __syncthreads();
        if (tid < NE) { const int c = (tb * 256) / CH_TOK; atomicAdd(&CNT[(l * NCHUNK + c) * 80 + tid], (unsigned)lh[tid]); }
    }
    __syncthreads();
}

DI void compute_pstart(CArgs& a, LAS unsigned char* lds, const int l, const int csel) {
    LAS int* ps = (LAS int*)(lds + LM_PSTART); LAS int* ts = (LAS int*)(lds + LM_TSTART);
    const unsigned* CNT = (const unsigned*)(a.ws + WS_CTL) + CW_CNT;
    const int ftid = fresh_tid(), wv = ftid >> 6, ln = ftid & 63;
    __syncthreads();
    if (wv < NCHUNK) {
        const int c = wv;
        const int cnt = (int)__hip_atomic_load(&CNT[(l * NCHUNK + c) * 80 + ln], __ATOMIC_RELAXED, __HIP_MEMORY_SCOPE_AGENT);
        const int pad = (cnt + 255) & ~255;
        int inc = pad;
#pragma unroll
        for (int off = 1; off < 64; off <<= 1) { const int t = shfl_up_i(inc, off, ln); if (ln >= off) inc += t; }
        const int exc = inc - pad;
        ps[c * 66 + ln] = exc; if (c == csel) ts[ln] = exc >> 8;
        if (ln == 63) { ps[c * 66 + 64] = inc; ps[c * 66 + 65] = inc + CH_TOK; if (c == csel) { ts[64] = inc >> 8; ts[65] = (inc + CH_TOK) >> 8; } }
    }
    __syncthreads();
}

DI void phase_place(CArgs& a, LAS unsigned char* lds, const int l, const bool dry) {
    compute_pstart(a, lds, l, 0);
    LAS int* ps = (LAS int*)(lds + LM_PSTART); LAS int* lh = (LAS int*)(lds + LM_LH); LAS int* lbase = (LAS int*)(lds + LM_LBASE);
    const int* EIDX = (const int*)(a.ws + WS_EIDX); int* TPOS = (int*)(a.ws + WS_TPOS); int* STOK = (int*)(a.ws + WS_STOK);
    unsigned* CNT = (unsigned*)(a.ws + WS_CTL) + CW_CNT; unsigned* CUR = (unsigned*)(a.ws + WS_CTL) + CW_CUR + (dry ? 2048 : 0);
    const int tid = fresh_tid();
    for (int tb = blockIdx.x; tb < NTOK / 256; tb += gridDim.x) {
        const int c = (tb * 256) / CH_TOK;
        __syncthreads();
        if (tid < 80) lh[tid] = 0;
        __syncthreads();
        int ee[8], rk[8];
        const size_t tok = (size_t)tb * 256 + (tid & 255);
        if (tid < 256) {
            const i32x4 e0 = *(const i32x4*)(EIDX + tok * 8), e1 = *(const i32x4*)(EIDX + tok * 8 + 4);
            ee[0] = e0[0]; ee[1] = e0[1]; ee[2] = e0[2]; ee[3] = e0[3]; ee[4] = e1[0]; ee[5] = e1[1]; ee[6] = e1[2]; ee[7] = e1[3];
#pragma unroll
            for (int k = 0; k < 8; ++k) rk[k] = atomicAdd((int*)&lh[ee[k]], 1);
        }
        __syncthreads();
        if (tid < NE) lbase[tid] = (int)atomicAdd(&CUR[(l * NCHUNK + c) * 80 + tid], (unsigned)lh[tid]);
        __syncthreads();
        if (tid < 256) {
            int pos[8];
#pragma unroll
            for (int k = 0; k < 8; ++k) { pos[k] = ps[c * 66 + ee[k]] + lbase[ee[k]] + rk[k]; STOK[(size_t)c * PMAX + pos[k]] = (int)tok; }
            *(i32x4*)(TPOS + tok * 8) = (i32x4){pos[0], pos[1], pos[2], pos[3]}; *(i32x4*)(TPOS + tok * 8 + 4) = (i32x4){pos[4], pos[5], pos[6], pos[7]};
        }
    }
    for (int pe = blockIdx.x; pe < 2 * NEX; pe += gridDim.x) {
        const int c = pe / NEX, e = pe % NEX; const int base = ps[c * 66 + e];
        if (e < NE) { const int cnt = (int)__hip_atomic_load(&CNT[(l * NCHUNK + c) * 80 + e], __ATOMIC_RELAXED, __HIP_MEMORY_SCOPE_AGENT); const int pad = (cnt + 255) & ~255;
            for (int i = cnt + tid; i < pad; i += 512) STOK[(size_t)c * PMAX + base + i] = c * CH_TOK; }
        else { for (int i = tid; i < CH_TOK; i += 512) STOK[(size_t)c * PMAX + base + i] = c * CH_TOK + i; }
    }
    __syncthreads();
}

DI void phase_comb(CArgs& a, LAS unsigned char* lds, const int l, const int c, const bool have_pstart, unsigned* queue) {
    if (!have_pstart) compute_pstart(a, lds, l, c);
    LAS int* ps = (LAS int*)(lds + LM_PSTART);
    LAS float* wff = (LAS float*)(lds + RING_OFF + 32768);
    const int tid = fresh_tid(), wid = tid >> 6, lane = tid & 63;
    if (l + 1 < DEPTH) { load_wff(a.w_in + (size_t)(l + 1) * D * INCOLS, wff); __syncthreads(); }
    const float* mod = (const float*)(a.ws + WS_MOD);
    const int* TPOS = (const int*)(a.ws + WS_TPOS); const float* GW = (const float*)(a.ws + WS_GW);
    const unsigned char* SLOT8 = (const unsigned char*)(a.ws + WS_R + R_SLOT) + (size_t)c * PMAX * 1024;
    bf16_t* U = (bf16_t*)(a.ws + WS_U); float* LF = (float*)(a.ws + WS_LOGF); bf16_t* XB = (bf16_t*)(a.ws + WS_XB);
    float g[16], bb[16];
    row_load_f32(a.ln_g + (size_t)(l * 2 + 1) * D, lane, g); row_load_f32(a.ln_b + (size_t)(l * 2 + 1) * D, lane, bb);
    const int shbase = ps[c * 66 + NE];
    typedef float f32x2 __attribute__((ext_vector_type(2)));
    const int rstride = gridDim.x * 8;
#define COMB_GRAB() ({ int v_ = 0; if (lane == 0) v_ = (int)xb_add(queue, 1u); __builtin_amdgcn_readfirstlane(v_); })
    int it = queue ? COMB_GRAB() : (int)(blockIdx.x * 8 + wid);
    const int itend = queue ? CH_TOK / 2 : CH_TOK, rs2 = queue ? CH_TOK / 2 : rstride;
    while (it < itend) {
        const int tr0 = it;
        it = queue ? COMB_GRAB() : it + 2 * rstride;
        int trr[2], tok[2]; bool okr[2];
#pragma unroll
        for (int q = 0; q < 2; ++q) { const int t = tr0 + q * rs2; okr[q] = t < CH_TOK; trr[q] = okr[q] ? t : tr0; tok[q] = c * CH_TOK + trr[q]; }
        i32x4 pp[2][2]; f32x4 ww[2][2];
#pragma unroll
        for (int q = 0; q < 2; ++q) { pp[q][0] = *(const i32x4*)(TPOS + (size_t)tok[q] * 8); pp[q][1] = *(const i32x4*)(TPOS + (size_t)tok[q] * 8 + 4);
            ww[q][0] = *(const f32x4*)(GW + (size_t)tok[q] * 8); ww[q][1] = *(const f32x4*)(GW + (size_t)tok[q] * 8 + 4); }
        u32x4 sw[2][9]; u32x4 xw[2][2]; float g2[2][16];
#pragma unroll
        for (int q = 0; q < 2; ++q) {
#pragma unroll
            for (int k = 0; k < 9; ++k) { const int pos = (k < 4) ? pp[q][0][k & 3] : ((k < 8) ? pp[q][1][k & 3] : shbase + trr[q]);
                sw[q][k] = __builtin_nontemporal_load((const u32x4*)(SLOT8 + (size_t)pos * 1024 + lane * 16)); }
#pragma unroll
            for (int j = 0; j < 2; ++j) xw[q][j] = __builtin_nontemporal_load((const u32x4*)(XB + (size_t)tok[q] * D + rc(lane) + 128 * j));
            row_load_f32(mod + (size_t)(l * 32 + (tok[q] >> 11)) * 6144 + 5120, lane, g2[q]);
        }
#pragma unroll
        for (int q = 0; q < 2; ++q) {
            float y[16];
#pragma unroll
            for (int i = 0; i < 16; ++i) y[i] = 0.f;
#pragma unroll
            for (int k = 0; k < 9; ++k) {
                const float wk = ((k < 4) ? ww[q][0][k & 3] : ((k < 8) ? ww[q][1][k & 3] : 1.0f)) * SLOT_INV;
#pragma unroll
                for (int d = 0; d < 4; ++d) { const f32x2 lo = __builtin_amdgcn_cvt_pk_f32_fp8((int)sw[q][k][d], false), hi = __builtin_amdgcn_cvt_pk_f32_fp8((int)sw[q][k][d], true);
                    y[d * 4 + 0] += wk * lo.x; y[d * 4 + 1] += wk * lo.y; y[d * 4 + 2] += wk * hi.x; y[d * 4 + 3] += wk * hi.y; }
            }
            float xv[16];
#pragma unroll
            for (int j = 0; j < 2; ++j) { const u32x4 w = xw[q][j];
                xv[j * 8 + 0] = bf_lo(w.x); xv[j * 8 + 1] = bf_hi(w.x); xv[j * 8 + 2] = bf_lo(w.y); xv[j * 8 + 3] = bf_hi(w.y); xv[j * 8 + 4] = bf_lo(w.z); xv[j * 8 + 5] = bf_hi(w.z); xv[j * 8 + 6] = bf_lo(w.w); xv[j * 8 + 7] = bf_hi(w.w); }
#pragma unroll
            for (int i = 0; i < 16; ++i) xv[i] = DN_ALPHA * xv[i] + (1.0f + g2[q][i]) * y[i];
            row_layernorm(xv, g, bb);
            if (okr[q]) {
                if (l + 1 < DEPTH) {
                    row_store_bf16(XB + (size_t)tok[q] * D, lane, xv);
                    emit_u_logf(xv, mod + (size_t)((l + 1) * 32 + (tok[q] >> 11)) * 6144, wff, a.b_forget + (l + 1) * 8, U + (size_t)tok[q] * D, LF + (size_t)tok[q] * 8, lane);
                } else row_store_f32_nt(a.out + (size_t)tok[q] * D, lane, xv);
            }
        }
    }
    __syncthreads();
}

DI void phase_attn(CArgs& a, LAS unsigned char* lds, const int var) {
    LAS unsigned char* ring = lds + RING_OFF;
    LAS float* bias2 = (LAS float*)(ring + att::BIAS_OFF);
    LAS float* wtot = (LAS float*)(lds + LM_LH);
    const bf16_t* proj = (const bf16_t*)(a.ws + WS_R + R_PROJ); bf16_t* Y = (bf16_t*)(a.ws + WS_R + R_Y);
    bf16_t* PART = (bf16_t*)(a.ws + WS_U); float* LSE = (float*)(a.ws + WS_LSE); const float* LF = (const float*)(a.ws + WS_LOGF);
    const int tid = fresh_tid(), wid = tid >> 6, lane = tid & 63;
    const int grp = __builtin_amdgcn_readfirstlane(tid >> 8);
    for (int bh = blockIdx.x; bh < NB * 8; bh += gridDim.x) {
        const int b = bh >> 3, h = bh & 7;
        const bf16_t* hm = proj + (size_t)(15 * b + 2 * h) * SEQ * 32;
        __syncthreads();
        {
            float v[4]; float run = 0.f;
#pragma unroll
            for (int i = 0; i < 4; ++i) { run += LF[(size_t)(b * SEQ + 4 * tid + i) * 8 + h]; v[i] = run; }
            float sc = run;
#pragma unroll
            for (int off = 1; off < 64; off <<= 1) { const float t = shfl_up_f(sc, off, lane); if (lane >= off) sc += t; }
            if (lane == 63) wtot[wid] = sc;
            __syncthreads();
            float base = sc - run;
            for (int w = 0; w < wid; ++w) base += wtot[w];
#pragma unroll
            for (int i = 0; i < 4; ++i) bias2[4 * tid + i] = -(base + v[i]) * LOG2E;
        }
        __syncthreads();
        if (var != 2) {
#pragma unroll 1
            for (int qb = 0; qb < SEQ / 256; ++qb) att::fx::fox_unit<60>(b, qb, hm, hm + QKV_T, hm + 2 * QKV_T, Y + h * 64, ring, bias2);
        }
        if (var != 1) { att::GenDil2 g3{b, 16, 1};
          att::attn_pass<1, att::GenDil2, 8>(ring, g3, hm + 3 * QKV_T, hm + 4 * QKV_T, hm + 5 * QKV_T, Y, 512 + h * 64, PART + (size_t)NTOK * 512, LSE + (size_t)NTOK * 8, nullptr, nullptr, nullptr, nullptr, h, var); }
        if (var != 1) { att::GenDil2 g2{b, 4, 4};
          att::attn_pass<1, att::GenDil2, 8>(ring, g2, hm + 3 * QKV_T, hm + 4 * QKV_T, hm + 5 * QKV_T, Y, 512 + h * 64, PART, LSE, nullptr, nullptr, nullptr, nullptr, h, var); }
        asm volatile("s_waitcnt vmcnt(0)" ::: "memory");
        __syncthreads();
        __builtin_amdgcn_fence(__ATOMIC_ACQUIRE, "agent");
        asm volatile("s_waitcnt vmcnt(0)" ::: "memory");
        if (var != 1) { att::GenDil2 g1{b, 1, 16};
          att::attn_pass<2, att::GenDil2, 8>(ring, g1, hm + 3 * QKV_T, hm + 4 * QKV_T, hm + 5 * QKV_T, Y, 512 + h * 64, nullptr, nullptr, PART, PART + (size_t)NTOK * 512, LSE, LSE + (size_t)NTOK * 8, h, var); }
    }
    __syncthreads();
}

DI void phase_comb(CArgs& a, LAS unsigned char* lds, const int l, const int c, const bool have_pstart, unsigned* queue);
DI void phase_gudn(CArgs& a, LAS unsigned char* lds, const int l, const int c, const int var, const int comb_c) {
    compute_pstart(a, lds, l, c);
    const LAS int* ts = (const LAS int*)(lds + LM_TSTART);
    LAS unsigned char* ring = lds + RING_OFF;
    const int ntiles = ts[NEX];
    const int cid = blockIdx.x, G = gridDim.x;
    const bool xmap = (G == 256);
    const int xx = cid & 7, sl = cid >> 3;
    const int lag = 0;
    if (comb_c >= 0 && lag) phase_comb(a, lds, l, comb_c, true, nullptr);
    int j0 = -1, e0 = 0, j1 = -1, e1 = 0;
#pragma unroll 1
    for (int r = 0;; ++r) {
        int j;
        if (xmap) { const int m = sl + 32 * r; j = 8 * (xx + 8 * (m >> 3)) + (m & 7); } else j = cid + r * G;
        const bool do_gu = j < ntiles;
        int e = 0;
        if (do_gu) { for (int k = 1; k < NEX; ++k) e += (ts[k] <= j) ? 1 : 0; } else j = -1;
        const int dj = lag ? j0 : j, de = lag ? e0 : e;
        if (j < 0 && dj < 0) break;
        if (j >= 0 && var != 2) {
            pg8::Gemm g{(const bf16_t*)(a.ws + WS_U), (const bf16_t*)(a.ws + WS_W + W_GU), D, D, D};
            pg8::TileOrder<true> S; S.pm = j; S.e = e; S.nN = 2; S.stok = (const int*)(a.ws + WS_STOK) + (size_t)c * PMAX; S.estride = (size_t)512 * D * 2;
            pg8::EpiGU E{(bf16_t*)(a.ws + WS_R + R_H)};
            pg8::gemm_phase<pg8::EpiGU, pg8::TileOrder<true>, true>(ring, g, S, E);
        }
        if (dj >= 0 && var != 1) {
            pg8::Gemm g{(const bf16_t*)(a.ws + WS_R + R_H), (const bf16_t*)(a.ws + WS_W + W_DN), 256, 256, 256};
            pg8::TileOrder<false> S; S.pm = dj; S.e = de; S.nN = 4; S.stok = nullptr; S.estride = (size_t)D * 256 * 2;
            pg8::EpiSlotF8 E{(var == 3) ? nullptr : (unsigned char*)(a.ws + WS_R + R_SLOT) + (size_t)c * PMAX * 1024};
            pg8::gemm_phase<pg8::EpiSlotF8, pg8::TileOrder<false>, true>(ring, g, S, E);
        }
        j0 = j; e0 = e;
    }
    if (comb_c >= 0 && !lag) phase_comb(a, lds, l, comb_c, true, nullptr);
    __syncthreads();
}

DI void phase_gudn_all(CArgs& a, LAS unsigned char* lds, const int l) {
    compute_pstart(a, lds, l, 0);
    const LAS int* ps = (const LAS int*)(lds + LM_PSTART);
    LAS unsigned char* ring = lds + RING_OFF;
    const int nt0 = ps[0 * 66 + 65] >> 8, nt1 = ps[1 * 66 + 65] >> 8, T = nt0 + nt1;
    const int cid = blockIdx.x, G = gridDim.x;
    const bool xmap = (G == 256);
    const int xx = cid & 7, sl = cid >> 3;
    unsigned* DONE = (unsigned*)(a.ws + WS_CTL) + CW_DONE + l;
    bool released = false;
    int npt[2][2] = {{0, 0}, {0, 0}}; bool havenpt = false;
#define GUDN_RELEASE() do { asm volatile("s_waitcnt vmcnt(0)" ::: "memory"); __syncthreads(); \
        if (fresh_tid() == 0) { __builtin_amdgcn_fence(__ATOMIC_RELEASE, "agent"); asm volatile("s_waitcnt vmcnt(0)" ::: "memory"); (void)xb_add(DONE, 1u); } released = true; } while (0)
#pragma unroll 1
    for (int r = 0;; ++r) {
        int j;
        if (xmap) { const int m = sl + 32 * r; j = 8 * (xx + 8 * (m >> 3)) + (m & 7); } else j = cid + r * G;
        if (j >= T) break;
        const int c = (j >= nt0) ? 1 : 0; const int jj = j - (c ? nt0 : 0);
        if (c == 1 && !released) GUDN_RELEASE();
        int e = 0;
        for (int k = 1; k < NEX; ++k) e += ((ps[c * 66 + k] >> 8) <= jj) ? 1 : 0;
        bf16_t* Hrel = (bf16_t*)(a.ws + WS_R + R_H) + ((ptrdiff_t)cid - (ptrdiff_t)jj) * 65536;
        {
            pg8::Gemm g{(const bf16_t*)(a.ws + WS_U), (const bf16_t*)(a.ws + WS_W + W_GU), D, D, D};
            pg8::TileOrder<true> S; S.pm = jj; S.e = e; S.nN = 2; S.stok = (const int*)(a.ws + WS_STOK) + (size_t)c * PMAX; S.estride = (size_t)512 * D * 2;
            S.havept = havenpt; S.pt[0][0] = npt[0][0]; S.pt[0][1] = npt[0][1]; S.pt[1][0] = npt[1][0]; S.pt[1][1] = npt[1][1];
            pg8::EpiGU E{Hrel};
            pg8::gemm_phase<pg8::EpiGU, pg8::TileOrder<true>, true>(ring, g, S, E);
        }
        {
            int jn; if (xmap) { const int m = sl + 32 * (r + 1); jn = 8 * (xx + 8 * (m >> 3)) + (m & 7); } else jn = cid + (r + 1) * G;
            havenpt = jn < T;
            if (havenpt) { const int cn = (jn >= nt0) ? 1 : 0, jjn = jn - (cn ? nt0 : 0);
                const int* sn = (const int*)(a.ws + WS_STOK) + (size_t)cn * PMAX + (size_t)jjn * 256;
                int R0, C0; pg8::stage_rc(fresh_tid() * 16, R0, C0);
#pragma unroll
                for (int h = 0; h < 2; ++h)
#pragma unroll
                    for (int i = 0; i < 2; ++i) npt[h][i] = sn[h * 128 + R0 + 64 * i]; }
        }
        {
            pg8::Gemm g{(const bf16_t*)Hrel, (const bf16_t*)(a.ws + WS_W + W_DN), 256, 256, 256};
            pg8::TileOrder<false> S; S.pm = jj; S.e = e; S.nN = 4; S.stok = nullptr; S.estride = (size_t)D * 256 * 2;
            pg8::EpiSlotF8 E{(unsigned char*)(a.ws + WS_R + R_SLOT) + (size_t)c * PMAX * 1024};
            pg8::gemm_phase<pg8::EpiSlotF8, pg8::TileOrder<false>, true>(ring, g, S, E);
        }
    }
    if (!released) GUDN_RELEASE();
#undef GUDN_RELEASE
    if (fresh_tid() == 0) {
        unsigned sp = 0u;
        while (xb_ld(DONE) < (unsigned)G) { __builtin_amdgcn_s_sleep(2); if (++sp > (1u << 22)) break; }
        __builtin_amdgcn_fence(__ATOMIC_ACQUIRE, "agent");
        asm volatile("s_waitcnt vmcnt(0)" ::: "memory");
    }
    __syncthreads();
    phase_comb(a, lds, l, 0, true, (unsigned*)(a.ws + WS_CTL) + CW_CQ + l);
    __syncthreads();
}

constexpr int NPH = 13, NGP = 1 + DEPTH * NPH;
__global__ void __launch_bounds__(512, 2) fwd(Args a_byval) {
    extern __shared__ __attribute__((aligned(16))) unsigned char smem[];
    LAS unsigned char* lds = (LAS unsigned char*)smem;
    LAS unsigned char* ring = lds + RING_OFF;
    const int tid = fresh_tid();
    if (tid < 4) ((LAS unsigned*)(lds + LM_BAR))[tid] = 0u;
    __syncthreads();
    XcdBarrier bar; int g0, g1, do_sync;
    { CArgs& a = *KARGS(); unsigned* barw = (unsigned*)(a.ws + WS_CTL);
      bar.bar = barw; bar.x = 0; bar.st = (volatile LAS unsigned*)(lds + LM_BAR);
      if (a.sync) bar = xcd_barrier_post(barw, (volatile LAS unsigned*)(lds + LM_BAR));
      g0 = a.g0; g1 = a.g1; do_sync = a.sync; }
#ifndef PHMASK
#define PHMASK 0xFFFFFFFFu
#endif
#define PHON(k) ((PHMASK >> (k)) & 1u)
#ifndef PROBE_DUP
#define PROBE_DUP -1
#endif
#ifndef PROBE_DRY
#define PROBE_DRY -1
#endif
#ifndef ATT_VAR
#define ATT_VAR 0
#endif
#ifndef MOE_VAR
#define MOE_VAR 0
#endif
#define REP(k) for (int rep_ = ((PROBE_DUP) == (k) || (PROBE_DRY) == (k)) ? 0 : 1; rep_ < 2; ++rep_)
#define IN(gp) (g0 <= (gp) && (gp) < g1)
#define SEAM(gp) do { if (do_sync && (gp) + 1 < g1) xcd_barrier(bar); } while (0)
    const int G = gridDim.x, cid = blockIdx.x;
#define Wl ((const bf16_t*)(a.ws + WS_W))
#define U ((bf16_t*)(a.ws + WS_U))
#define PROJ ((bf16_t*)(a.ws + WS_R + R_PROJ))
#define Y ((bf16_t*)(a.ws + WS_R + R_Y))
#define HB ((bf16_t*)(a.ws + WS_R + R_H))
#define SLOT ((bf16_t*)(a.ws + WS_R + R_SLOT))
#define mod ((const float*)(a.ws + WS_MOD))
#define cosT ((const float*)(a.ws + WS_ROPE))
#define sinT ((const float*)(a.ws + WS_ROPE) + 2048 * 32)

    REP(16) if (PHON(16) && IN(0)) { CArgs& a = *KARGS(); phase_pre(a, ring); SEAM(0); }
    for (int l = 0; l < DEPTH; ++l) {
        const int gb = 1 + l * NPH;
        REP(0) if (PHON(0) && IN(gb + 0)) { CArgs& a = *KARGS(); phase_w(a, ring, l); SEAM(gb + 0); }
        REP(1) if (PHON(1) && IN(gb + 1)) { CArgs& a = *KARGS();
            pg8::Gemm g{U, (const bf16_t*)((const unsigned char*)Wl + W_IN), D, D, D}; pg8::StaticOrder S; S.init(NTOK, NPROJ, G, cid);
            pg8::EpiInProj E{PROJ, a.b_gate + l * 2048, cosT, sinT};
            pg8::gemm_phase<pg8::EpiInProj, pg8::StaticOrder, true>(ring, g, S, E);
            SEAM(gb + 1);
        }
        REP(2) if (PHON(2) && IN(gb + 2)) { CArgs& a = *KARGS(); phase_attn(a, lds, ((PROBE_DUP == 2) && rep_ == 0) ? ATT_VAR : 0); SEAM(gb + 2); }
        REP(3) if (PHON(3) && IN(gb + 3)) { CArgs& a = *KARGS();
            pg8::Gemm g{Y, (const bf16_t*)((const unsigned char*)Wl + W_BF), D, D, D}; pg8::StaticOrder S; S.init(NTOK, D, G, cid);
            pg8::EpiBranchFused E{U, PROJ};
            pg8::gemm_phase<pg8::EpiBranchFused, pg8::StaticOrder, true>(ring, g, S, E);
            SEAM(gb + 3);
        }
        REP(5) if (PHON(5) && IN(gb + 5)) { CArgs& a = *KARGS();
            pg8::Gemm g{U, (const bf16_t*)((const unsigned char*)Wl + W_O), D, D, D}; pg8::StaticOrder S; S.init(NTOK, D, G, cid);
            pg8::EpiOut E{l == 0 ? a.x : nullptr, (bf16_t*)(a.ws + WS_XB), mod + (size_t)l * 32 * 6144 + 2048};
            pg8::gemm_phase<pg8::EpiOut, pg8::StaticOrder, true>(ring, g, S, E);
            SEAM(gb + 5);
        }
        REP(6) if (PHON(6) && IN(gb + 6)) { CArgs& a = *KARGS(); phase_ln1(a, l, (PROBE_DRY == 6) && rep_ == 0); SEAM(gb + 6); }
        REP(7) if (PHON(7) && IN(gb + 7)) { CArgs& a = *KARGS();
            pg8::Gemm g{U, (const bf16_t*)((const unsigned char*)Wl + W_R), D, D, D}; pg8::StaticOrder S; S.init(NTOK, 256, G, cid);
            pg8::EpiRouter E{(float*)(a.ws + WS_LOGITS)};
            pg8::gemm_phase<pg8::EpiRouter, pg8::StaticOrder, true>(ring, g, S, E);
            SEAM(gb + 7);
        }
        REP(8) if (PHON(8) && IN(gb + 8)) { CArgs& a = *KARGS(); phase_route(a, lds, l, (PROBE_DRY == 8) && rep_ == 0); SEAM(gb + 8); }
        REP(9) if (PHON(9) && IN(gb + 9)) { CArgs& a = *KARGS(); phase_place(a, lds, l, (PROBE_DRY == 9) && rep_ == 0); SEAM(gb + 9); }
        static_assert(NCHUNK == 2, "phase program below is written for two chunks");
#if MK_ONE_LAUNCH
        if (PHON(10) && IN(gb + 10)) { CArgs& a = *KARGS(); phase_gudn_all(a, lds, l); SEAM(gb + 10); }
#else
        if (PHON(10) && IN(gb + 10)) { CArgs& a = *KARGS(); phase_gudn(a, lds, l, 0, 0, -1); SEAM(gb + 10); }
        if (PHON(11) && IN(gb + 11)) { CArgs& a = *KARGS(); phase_gudn(a, lds, l, 1, 0, 0); SEAM(gb + 11); }
#endif
        REP(12) if (PHON(12) && IN(gb + 12)) { CArgs& a = *KARGS(); phase_comb(a, lds, l, 1, false, nullptr); SEAM(gb + 12); }
    }
}

extern "C" void kernel_launch(void* const* d_in, const int* in_sizes, int n_in, void* d_out, int out_size, void* d_ws, size_t ws_size, hipStream_t stream) {
    static int grid = 0;
    if (grid == 0) {
        if (n_in != 20 || ws_size < WS_END2 + ((PROBE_DRY >= 0) ? DRY_BYTES : 0)) { fprintf(stderr, "kernel_launch: need 20 inputs and %zu bytes of workspace (got %d, %zu)\n", (size_t)WS_END2, n_in, ws_size); grid = -1; return; }
        int dev = 0, cus = 0;
        if (hipGetDevice(&dev) != hipSuccess || hipDeviceGetAttribute(&cus, hipDeviceAttributeMultiprocessorCount, dev) != hipSuccess) { grid = -1; return; }
        if (hipFuncSetAttribute((const void*)fwd, hipFuncAttributeMaxDynamicSharedMemorySize, LDS_BYTES) != hipSuccess) { fprintf(stderr, "kernel_launch: hipFuncSetAttribute failed\n"); grid = -1; return; }
        int per_cu = 0;
        if (hipOccupancyMaxActiveBlocksPerMultiprocessor(&per_cu, fwd, 512, LDS_BYTES) != hipSuccess || per_cu < 1) { fprintf(stderr, "kernel_launch: occupancy query says %d\n", per_cu); grid = -1; return; }
        grid = cus;
    }
    if (grid <= 0) return;
    hipMemsetAsync((char*)d_ws + WS_CTL, 0, CTL_BYTES, stream);
    Args a{};
    const float** f = (const float**)&a;
    for (int i = 0; i < 20; ++i) f[i] = (const float*)d_in[i];
    a.out = (float*)d_out; a.ws = (unsigned char*)d_ws; a.pad = 0;
#if MK_ONE_LAUNCH
    a.g0 = 0; a.g1 = NGP; a.sync = 1;
    fwd<<<dim3(grid), dim3(512), LDS_BYTES, stream>>>(a);
#else
    for (int gp = 0; gp < NGP; ++gp) { a.g0 = gp; a.g1 = gp + 1; a.sync = 0; fwd<<<dim3(grid), dim3(512), LDS_BYTES, stream>>>(a); }
#endif
}
```
